# Optimizing an MI355X kernel written in HIP

```python
import jax
import jax.numpy as jnp
from jax import lax
import numpy as np

D_MODEL = 2048
BATCH = 8
SEQ = 2048
DEPTH = 2

GRID_W = 64
CTX_LEN = 256
NORM_EPS = 1e-6

GROUP_WIDTH = D_MODEL // 4

MLA_NOPE = 128
MLA_ROPE = 64
MLA_V = 128
MLA_HEADS = GROUP_WIDTH // MLA_V
MLA_Q_RANK = 384
MLA_KV_RANK = 128
ROPE_BASE = 10000.0
Q_BLOCK = 128

RWKV_HEAD = 64
RWKV_HEADS = GROUP_WIDTH // RWKV_HEAD
RWKV_WIDTH = RWKV_HEADS * RWKV_HEAD
DECAY_RANK = 96
ICL_RANK = 96
GATE_RANK = 256
RWKV_GN_EPS = 64e-5

POOL_WINDOWS = (2, 4, 8, 16)
POOL_WIDTH = GROUP_WIDTH
POOL_GROUP = POOL_WIDTH // len(POOL_WINDOWS)

CONV_WIDTH = GROUP_WIDTH
CONV_TAPS = 3

FF_HIDDEN = 4 * D_MODEL

MLA_COLS = MLA_Q_RANK + MLA_KV_RANK + MLA_ROPE
RWKV_COLS = 3 * RWKV_WIDTH + 2 * DECAY_RANK + 2 * ICL_RANK + GATE_RANK
POOL_COLS = POOL_WIDTH
CONV_COLS = 3 * CONV_WIDTH
IN_COLS = MLA_COLS + RWKV_COLS + POOL_COLS + CONV_COLS
MIX_WIDTH = MLA_HEADS * MLA_V + RWKV_WIDTH + POOL_WIDTH + CONV_WIDTH

kernel_name = "hybrid_mla_rwkv7_pool_conv_dit_trunk"


def split_cols(x, sizes):
    return jnp.split(x, np.cumsum(sizes)[:-1].tolist(), axis=-1)


def rmsnorm(x, g):
    xf = x.astype(jnp.float32)
    y = xf * lax.rsqrt(jnp.mean(jnp.square(xf), axis=-1, keepdims=True) + NORM_EPS)
    return (y * g.astype(jnp.float32)).astype(x.dtype)


def neighbours(u):
    zero = jnp.zeros_like(u[:, :1])
    prev = jnp.concatenate([zero, u[:, :-1]], axis=1)
    nxt = jnp.concatenate([u[:, 1:], zero], axis=1)
    return prev, nxt


def axial_rope_tables(n_tokens):
    rows = n_tokens // GRID_W
    row = jnp.repeat(jnp.arange(rows), GRID_W)
    col = jnp.tile(jnp.arange(GRID_W), rows)
    pos = jnp.stack([row, col], axis=-1).astype(jnp.float32)
    axis_dim = MLA_ROPE // 2
    inv_freq = ROPE_BASE ** (-jnp.arange(0, axis_dim, 2, dtype=jnp.float32) / axis_dim)
    ang = pos[:, :, None] * inv_freq
    return jnp.cos(ang), jnp.sin(ang)


def apply_rope(x, cos, sin):
    xf = x.astype(jnp.float32).reshape(x.shape[:-1] + (2, 2, MLA_ROPE // 4))
    x1, x2 = xf[..., 0, :], xf[..., 1, :]
    cs, sn = cos[None, :, None], sin[None, :, None]
    out = jnp.stack([x1 * cs - x2 * sn, x2 * cs + x1 * sn], axis=-2)
    return out.reshape(x.shape).astype(x.dtype)


def mla_keys(f_kv, f_kr, kv_norm_g, w_ukv, rope):
    b, n, _ = f_kv.shape
    kv = (rmsnorm(f_kv, kv_norm_g) @ w_ukv).reshape(b, n, MLA_HEADS, MLA_NOPE + MLA_V)
    k_nope, v = kv[..., :MLA_NOPE], kv[..., MLA_NOPE:]
    k_pe = f_kr[:, :, None, :]
    if rope is not None:
        k_pe = apply_rope(k_pe, *rope)
    return k_nope, k_pe[:, :, 0], v


def mla_queries(f_q, q_norm_g, w_uq, rope):
    b, n, _ = f_q.shape
    q = (rmsnorm(f_q, q_norm_g) @ w_uq).reshape(b, n, MLA_HEADS, MLA_NOPE + MLA_ROPE)
    q_nope, q_pe = q[..., :MLA_NOPE], q[..., MLA_NOPE:]
    if rope is not None:
        q_pe = apply_rope(q_pe, *rope)
    return q_nope, q_pe


def mla_attend(q_nope, q_pe, k_nope, k_pe, v):
    scale = (MLA_NOPE + MLA_ROPE) ** -0.5
    s = (jnp.einsum('bqhd,bkhd->bhqk', q_nope, k_nope)
         + jnp.einsum('bqhr,bkr->bhqk', q_pe, k_pe)).astype(jnp.float32) * scale
    p = jax.nn.softmax(s, axis=-1).astype(v.dtype)
    o = jnp.einsum('bhqk,bkhd->bqhd', p, v)
    return o.reshape(o.shape[0], o.shape[1], MLA_HEADS * MLA_V)


def mla_attend_blocked(q_nope, q_pe, k_nope, k_pe, v):
    b, n = q_nope.shape[:2]
    nb = n // Q_BLOCK
    qn = q_nope.reshape(b, nb, Q_BLOCK, MLA_HEADS, MLA_NOPE).swapaxes(0, 1)
    qp = q_pe.reshape(b, nb, Q_BLOCK, MLA_HEADS, MLA_ROPE).swapaxes(0, 1)
    o = lax.map(lambda qs: mla_attend(qs[0], qs[1], k_nope, k_pe, v), (qn, qp))
    return o.swapaxes(0, 1).reshape(b, n, MLA_HEADS * MLA_V)


def mla_mixer(fa_lat, fa_ctx, p, rope, need_ctx):
    q_l, kv_l, kr_l = split_cols(fa_lat, (MLA_Q_RANK, MLA_KV_RANK, MLA_ROPE))
    q_c, kv_c, kr_c = split_cols(fa_ctx, (MLA_Q_RANK, MLA_KV_RANK, MLA_ROPE))
    kn_c, kp_c, v_c = mla_keys(kv_c, kr_c, p['mla_kv_norm_g'], p['mla_w_ukv'], None)
    kn_l, kp_l, v_l = mla_keys(kv_l, kr_l, p['mla_kv_norm_g'], p['mla_w_ukv'], rope)
    qn_l, qp_l = mla_queries(q_l, p['mla_q_norm_g'], p['mla_w_uq'], rope)
    k_nope = jnp.concatenate([kn_c, kn_l], axis=1)
    k_pe = jnp.concatenate([kp_c, kp_l], axis=1)
    v = jnp.concatenate([v_c, v_l], axis=1)
    out_l = mla_attend_blocked(qn_l, qp_l, k_nope, k_pe, v)
    out_c = None
    if need_ctx:
        qn_c, qp_c = mla_queries(q_c, p['mla_q_norm_g'], p['mla_w_uq'], None)
        out_c = mla_attend(qn_c, qp_c, kn_c, kp_c, v_c)
    return out_l, out_c


def rwkv_prepare(f, p):
    f = f.astype(jnp.float32)
    b, n, _ = f.shape
    prev, nxt = neighbours(f)
    f = f + p['rwkv_mu'] * (0.5 * (prev + nxt) - f)
    r, k, v, wl, al, gl = split_cols(
        f, (RWKV_WIDTH, RWKV_WIDTH, RWKV_WIDTH, 2 * DECAY_RANK, 2 * ICL_RANK, GATE_RANK))
    wl = wl.reshape(b, n, 2, DECAY_RANK)
    al = al.reshape(b, n, 2, ICL_RANK)
    w = -jax.nn.softplus(-(p['rwkv_w0'] + jnp.einsum('bndr,drc->bndc', jnp.tanh(wl), p['rwkv_w2']))) - 0.5
    decay = jnp.exp(-jnp.exp(w))
    a = jax.nn.sigmoid(p['rwkv_a0'] + jnp.einsum('bndr,drc->bndc', al, p['rwkv_a2']))
    g = jax.nn.sigmoid(gl) @ p['rwkv_g2']

    def heads(t):
        return t.reshape(t.shape[:-1] + (RWKV_HEADS, RWKV_HEAD))

    kk = heads(k * p['rwkv_k_k'])
    kk = kk / jnp.maximum(jnp.sqrt(jnp.sum(kk * kk, axis=-1, keepdims=True)), 1e-12)
    k_dir = heads(k[:, :, None] * (1.0 + (a - 1.0) * p['rwkv_k_a']))
    r_h, v_h = heads(r), heads(v)
    b_dir = kk[:, :, None] * heads(a)
    bonus = jnp.einsum('bnhk,bndhk,hk->bnh', r_h, k_dir, p['rwkv_r_k'])[..., None] * v_h
    return {'r': r_h, 'w': heads(decay), 'k': k_dir, 'v': v_h, 'a': -kk, 'b': b_dir,
            'g': g, 'bonus': bonus}


def dir_inputs(feats, d):
    return (feats['r'], feats['w'][:, :, d], feats['k'][:, :, d], feats['v'], feats['a'], feats['b'][:, :, d])


def wkv_scan(state, r, w, k, v, a, b, reverse, with_out):
    xs = tuple(t.swapaxes(0, 1) for t in (r, w, k, v, a, b))

    def step(S, inp):
        r_t, w_t, k_t, v_t, a_t, b_t = inp
        sa = jnp.einsum('bhvk,bhk->bhv', S, a_t)
        S = S * w_t[:, :, None, :] + sa[..., None] * b_t[:, :, None, :] + v_t[..., None] * k_t[:, :, None, :]
        y = jnp.einsum('bhvk,bhk->bhv', S, r_t) if with_out else None
        return S, y

    state, ys = lax.scan(step, state, xs, reverse=reverse)
    return state, (ys.swapaxes(0, 1) if with_out else None)


def rwkv_output(y, feats, p, dtype):
    b, n = y.shape[:2]
    mean = jnp.mean(y, axis=-1, keepdims=True)
    var = jnp.mean(jnp.square(y - mean), axis=-1, keepdims=True)
    yn = ((y - mean) * lax.rsqrt(var + RWKV_GN_EPS)).reshape(b, n, RWKV_WIDTH)
    yn = yn * p['rwkv_ln_g'] + p['rwkv_ln_b']
    out = (yn + feats['bonus'].reshape(b, n, RWKV_WIDTH)) * feats['g']
    return out.astype(dtype)


def rwkv_mixer(fb_lat, fb_ctx, p, need_ctx):
    dtype = fb_lat.dtype
    fl = rwkv_prepare(fb_lat, p)
    fc = rwkv_prepare(fb_ctx, p)
    zero = jnp.zeros((fb_lat.shape[0], RWKV_HEADS, RWKV_HEAD, RWKV_HEAD), jnp.float32)
    s_cf, y_cf = wkv_scan(zero, *dir_inputs(fc, 0), reverse=False, with_out=need_ctx)
    s_cb, y_cb = wkv_scan(zero, *dir_inputs(fc, 1), reverse=True, with_out=need_ctx)
    _, y_lf = wkv_scan(s_cf, *dir_inputs(fl, 0), reverse=False, with_out=True)
    _, y_lb = wkv_scan(s_cb, *dir_inputs(fl, 1), reverse=True, with_out=True)
    out_l = rwkv_output(y_lf + y_lb, fl, p, dtype)
    out_c = rwkv_output(y_cf + y_cb, fc, p, dtype) if need_ctx else None
    return out_l, out_c


def pool_mixer(u, p):
    b, n, _ = u.shape
    uf = u.astype(jnp.float32)
    cs = jnp.concatenate([jnp.zeros_like(uf[:, :1]), jnp.cumsum(uf, axis=1)], axis=1)
    t = jnp.arange(n)
    groups = []
    for gi, win in enumerate(POOL_WINDOWS):
        sl = slice(gi * POOL_GROUP, (gi + 1) * POOL_GROUP)
        lo = jnp.clip(t - win // 2, 0, n)
        hi = jnp.clip(t + win // 2, 0, n)
        cnt = (hi - lo).astype(jnp.float32)[:, None]
        csg = cs[..., sl]
        mean = (jnp.take(csg, hi, axis=1) - jnp.take(csg, lo, axis=1)) / cnt
        groups.append(mean - uf[..., sl])
    z = jnp.stack(groups, axis=2)
    z = jnp.einsum('bngi,gio->bngo', z, p['pool_w'].astype(jnp.float32)).reshape(b, n, POOL_WIDTH)
    return (z * p['pool_scale']).astype(u.dtype)


def conv_mixer(fd, p):
    gb, gc, hx = split_cols(fd, (CONV_WIDTH, CONV_WIDTH, CONV_WIDTH))
    u = gc * hx
    prev, nxt = neighbours(u)
    w = p['conv_w']
    z = w[0] * prev + w[1] * u + w[2] * nxt
    return gb * z


def sq_relu_mlp(x, w1, w2):
    return jnp.square(jax.nn.relu(x @ w1)) @ w2


def trunk_layer(h, hc, c, c_ctx, p, rope, need_ctx):
    mod = jax.nn.silu(c) @ p['ada_w'] + p['ada_b']
    mod_c = jax.nn.silu(c_ctx) @ p['ada_w'] + p['ada_b']
    sh1, sc1, gt1, sh2, sc2, gt2 = [m[:, None, :] for m in jnp.split(mod, 6, axis=-1)]
    sh1c, sc1c, gt1c, sh2c, sc2c, gt2c = jnp.split(mod_c, 6, axis=-1)

    xn = rmsnorm(h, p['norm1_g']) * (1.0 + sc1) + sh1
    xc = rmsnorm(hc, p['norm1_g']) * (1.0 + sc1c) + sh1c
    col_sizes = (MLA_COLS, RWKV_COLS, POOL_COLS, CONV_COLS)
    fl = split_cols(xn @ p['w_in'], col_sizes)
    fc = split_cols(xc @ p['w_in'], col_sizes)

    att_l, att_c = mla_mixer(fl[0], fc[0], p, rope, need_ctx)
    rw_l, rw_c = rwkv_mixer(fl[1], fc[1], p, need_ctx)
    pool_l = pool_mixer(fl[2], p)
    conv_l = conv_mixer(fl[3], p)
    mixed = jnp.concatenate([att_l, rw_l, pool_l, conv_l], axis=-1) @ p['w_out']
    h = h + gt1 * mixed
    h = h + gt2 * sq_relu_mlp(rmsnorm(h, p['norm2_g']) * (1.0 + sc2) + sh2, p['mlp_w1'], p['mlp_w2'])

    if need_ctx:
        pool_c = pool_mixer(fc[2], p)
        conv_c = conv_mixer(fc[3], p)
        mixed_c = jnp.concatenate([att_c, rw_c, pool_c, conv_c], axis=-1) @ p['w_out']
        hc = hc + gt1c * mixed_c
        hc = hc + gt2c * sq_relu_mlp(rmsnorm(hc, p['norm2_g']) * (1.0 + sc2c) + sh2c, p['mlp_w1'], p['mlp_w2'])
    return h, hc


def setup_inputs(seed: int = 0) -> dict:
    key = jax.random.key(seed)
    ks = jax.random.split(key, 32)
    f32 = jnp.float32

    def nrm(k, shape, scale):
        return scale * jax.random.normal(k, shape, f32)

    L = DEPTH
    return {
        "x": nrm(ks[0], (BATCH, SEQ, D_MODEL), 1.0),
        "c": nrm(ks[1], (BATCH, D_MODEL), 1.0),
        "ctx": nrm(ks[2], (BATCH, CTX_LEN, D_MODEL), 1.0),
        "c_ctx": nrm(ks[3], (D_MODEL,), 1.0),
        "ada_w": nrm(ks[4], (L, D_MODEL, 6 * D_MODEL), 0.5 * D_MODEL ** -0.5),
        "ada_b": nrm(ks[5], (L, 6 * D_MODEL), 0.01),
        "norm1_g": 1.0 + nrm(ks[6], (L, D_MODEL), 0.02),
        "norm2_g": 1.0 + nrm(ks[7], (L, D_MODEL), 0.02),
        "w_in": nrm(ks[8], (L, D_MODEL, IN_COLS), D_MODEL ** -0.5),
        "mla_q_norm_g": 1.0 + nrm(ks[9], (L, MLA_Q_RANK), 0.02),
        "mla_w_uq": nrm(ks[10], (L, MLA_Q_RANK, MLA_HEADS * (MLA_NOPE + MLA_ROPE)), MLA_Q_RANK ** -0.5),
        "mla_kv_norm_g": 1.0 + nrm(ks[11], (L, MLA_KV_RANK), 0.02),
        "mla_w_ukv": nrm(ks[12], (L, MLA_KV_RANK, MLA_HEADS * (MLA_NOPE + MLA_V)), MLA_KV_RANK ** -0.5),
        "rwkv_mu": jax.random.uniform(ks[13], (L, RWKV_COLS), f32),
        "rwkv_w0": jax.random.uniform(ks[14], (L, 2, RWKV_WIDTH), f32, -6.0, -1.0),
        "rwkv_w2": nrm(ks[15], (L, 2, DECAY_RANK, RWKV_WIDTH), 0.5 * DECAY_RANK ** -0.5),
        "rwkv_a0": nrm(ks[16], (L, 2, RWKV_WIDTH), 0.1),
        "rwkv_a2": nrm(ks[17], (L, 2, ICL_RANK, RWKV_WIDTH), 0.5 * ICL_RANK ** -0.5),
        "rwkv_g2": nrm(ks[18], (L, GATE_RANK, RWKV_WIDTH), GATE_RANK ** -0.5),
        "rwkv_k_k": 1.0 + nrm(ks[19], (L, RWKV_WIDTH), 0.1),
        "rwkv_k_a": 1.0 + nrm(ks[20], (L, RWKV_WIDTH), 0.1),
        "rwkv_r_k": nrm(ks[21], (L, RWKV_HEADS, RWKV_HEAD), 0.1),
        "rwkv_ln_g": 1.0 + nrm(ks[22], (L, RWKV_WIDTH), 0.02),
        "rwkv_ln_b": nrm(ks[23], (L, RWKV_WIDTH), 0.01),
        "pool_w": nrm(ks[24], (L, len(POOL_WINDOWS), POOL_GROUP, POOL_GROUP), POOL_GROUP ** -0.5),
        "pool_scale": 1.0 + nrm(ks[25], (L, POOL_WIDTH), 0.1),
        "conv_w": nrm(ks[26], (L, CONV_TAPS, CONV_WIDTH), CONV_TAPS ** -0.5),
        "w_out": nrm(ks[27], (L, MIX_WIDTH, D_MODEL), MIX_WIDTH ** -0.5),
        "mlp_w1": nrm(ks[28], (L, D_MODEL, FF_HIDDEN), D_MODEL ** -0.5),
        "mlp_w2": nrm(ks[29], (L, FF_HIDDEN, D_MODEL), FF_HIDDEN ** -0.5),
        "final_norm_g": 1.0 + nrm(ks[30], (D_MODEL,), 0.02),
    }


def reference(x, c, ctx, c_ctx, ada_w, ada_b, norm1_g, norm2_g, w_in, mla_q_norm_g, mla_w_uq,
              mla_kv_norm_g, mla_w_ukv, rwkv_mu, rwkv_w0, rwkv_w2, rwkv_a0, rwkv_a2, rwkv_g2,
              rwkv_k_k, rwkv_k_a, rwkv_r_k, rwkv_ln_g, rwkv_ln_b, pool_w, pool_scale, conv_w,
              w_out, mlp_w1, mlp_w2, final_norm_g):
    rope = axial_rope_tables(x.shape[1])
    h, hc = x, ctx
    for l in range(DEPTH):
        p = {
            'ada_w': ada_w[l], 'ada_b': ada_b[l], 'norm1_g': norm1_g[l], 'norm2_g': norm2_g[l],
            'w_in': w_in[l], 'mla_q_norm_g': mla_q_norm_g[l], 'mla_w_uq': mla_w_uq[l],
            'mla_kv_norm_g': mla_kv_norm_g[l], 'mla_w_ukv': mla_w_ukv[l],
            'rwkv_mu': rwkv_mu[l], 'rwkv_w0': rwkv_w0[l], 'rwkv_w2': rwkv_w2[l],
            'rwkv_a0': rwkv_a0[l], 'rwkv_a2': rwkv_a2[l], 'rwkv_g2': rwkv_g2[l],
            'rwkv_k_k': rwkv_k_k[l], 'rwkv_k_a': rwkv_k_a[l], 'rwkv_r_k': rwkv_r_k[l],
            'rwkv_ln_g': rwkv_ln_g[l], 'rwkv_ln_b': rwkv_ln_b[l],
            'pool_w': pool_w[l], 'pool_scale': pool_scale[l], 'conv_w': conv_w[l],
            'w_out': w_out[l], 'mlp_w1': mlp_w1[l], 'mlp_w2': mlp_w2[l],
        }
        h, hc = trunk_layer(h, hc, c, c_ctx, p, rope, l < DEPTH - 1)
    return rmsnorm(h, final_norm_g)
```

```cpp
#include <hip/hip_runtime.h>
#include <hip/hip_cooperative_groups.h>
#include <cstdio>
namespace cg = cooperative_groups;

#ifndef ONE_LAUNCH
#define ONE_LAUNCH 1
#endif

#ifndef SUBM
#define SUBM 15
#endif
#ifndef REPMASK
#define REPMASK 0
#endif
#ifndef REPN
#define REPN 1
#endif
#ifndef SCANREP
#define SCANREP 0
#endif
#ifndef SYNCREP
#define SYNCREP 0
#endif
#ifndef PHMASK
#define PHMASK 0xfff
#endif
#define DI __device__ __forceinline__
#define LAS __attribute__((address_space(3)))
typedef unsigned short u16;
typedef short bf16x8 __attribute__((ext_vector_type(8)));
typedef short s16x4 __attribute__((ext_vector_type(4)));
typedef float f32x2 __attribute__((ext_vector_type(2)));
typedef float f32x4 __attribute__((ext_vector_type(4)));
typedef float f32x16 __attribute__((ext_vector_type(16)));
typedef unsigned u32x2 __attribute__((ext_vector_type(2)));
typedef unsigned u32x4 __attribute__((ext_vector_type(4)));
typedef __bf16 bf16x2_t __attribute__((ext_vector_type(2)));

constexpr int D = 2048, NB = 8, SEQ = 2048, CTX = 256;
constexpr int NCT = NB * CTX, NLT = NB * SEQ, NTOK = NCT + NLT;
constexpr int FN = 4864;
constexpr int C_KV = 384, C_KR = 512, C_RW = 576, C_POOL = 2752, C_GB = 3264, C_GC = 3776, C_HX = 4288;
constexpr int KP = CTX + SEQ;
constexpr int FF = 8192, FFP = 8192 + 64;
constexpr int LDS_BYTES = 131072 + 16;

constexpr size_t al256(size_t x) { return (x + 255) & ~(size_t)255; }
constexpr size_t SZ_UQ = 768 * 384 * 2, SZ_UKV = 1024 * 256 * 2, SZ_LORA = 2560 * 640 * 2, SZ_POOLW = 512 * 512 * 2;
constexpr size_t SZ_SMALL = SZ_UQ + SZ_UKV + SZ_LORA + SZ_POOLW;
constexpr size_t OFF_SMALL = 0;
constexpr size_t OFF_BAR = 2 * SZ_SMALL;
constexpr size_t ZERO_BYTES = OFF_BAR + 16384;
constexpr size_t OFF_MOD = al256(ZERO_BYTES);
constexpr size_t SZ_MOD = (size_t)2 * 9 * 6 * 2048 * 4;
constexpr size_t OFF_ROPE = al256(OFF_MOD + SZ_MOD);
constexpr size_t OFF_WIN = al256(OFF_ROPE + 64 * 16 * 2 * 4);
constexpr size_t OFF_WOUT = al256(OFF_WIN + (size_t)FN * 2048 * 2);
constexpr size_t OFF_W1 = al256(OFF_WOUT + (size_t)2048 * 2048 * 2);
constexpr size_t OFF_W2 = al256(OFF_W1 + (size_t)FF * 2048 * 2);
constexpr size_t OFF_HCTX = al256(OFF_W2 + (size_t)FFP * 2048 * 2);
constexpr size_t OFF_ACT = al256(OFF_HCTX + (size_t)NCT * 2048 * 4);
constexpr size_t OFF_RKV = al256(OFF_ACT + (size_t)NTOK * 2048 * 2);
constexpr size_t OFF_ALORA = al256(OFF_RKV + (size_t)3 * NTOK * 512 * 4);
constexpr size_t OFF_APOOL = al256(OFF_ALORA + (size_t)NTOK * 640 * 2);
constexpr size_t OFF_AQ = al256(OFF_APOOL + (size_t)NTOK * 512 * 2);
constexpr size_t OFF_AKV = al256(OFF_AQ + (size_t)NTOK * 384 * 2);
constexpr size_t OFF_KPE = al256(OFF_AKV + (size_t)NTOK * 256 * 2);
constexpr size_t OFF_X = al256(OFF_KPE + (size_t)NTOK * 64 * 2);
constexpr size_t X_F = OFF_X, X_H1 = OFF_X;
constexpr size_t X_DEC = OFF_X;
constexpr size_t X_AA = al256(X_DEC + (size_t)2 * NTOK * 512 * 4);
constexpr size_t X_G = al256(X_AA + (size_t)2 * NTOK * 512 * 2);
constexpr size_t X_Q = al256(X_G + (size_t)NTOK * 512 * 2);
constexpr size_t X_K = al256(X_Q + (size_t)NTOK * 768 * 2);
constexpr size_t X_VT = al256(X_K + (size_t)NTOK * 768 * 2);
constexpr size_t X_Y = al256(X_VT + (size_t)NTOK * 512 * 2);
constexpr size_t X_END = al256(X_Y + (size_t)2 * NTOK * 512 * 4);
constexpr size_t WS_END = OFF_X + (size_t)NTOK * FFP * 2;
static_assert(X_END <= WS_END, "region X overflow");
static_assert(X_F + (size_t)NTOK * FN * 2 <= WS_END, "F overflow");

struct Params {
    const float* in[31];
    float* out;
    unsigned char* ws;
    int ph_lo, ph_hi, use_sync, pad;
};
typedef const __attribute__((address_space(4))) Params* PP;
enum { I_X = 0, I_C, I_CTX, I_CCTX, I_ADAW, I_ADAB, I_N1G, I_N2G, I_WIN, I_QNG, I_WUQ, I_KVNG, I_WUKV, I_MU, I_W0, I_W2, I_A0, I_A2, I_G2,
       I_KK, I_KA, I_RK, I_LNG, I_LNB, I_POOLW, I_POOLS, I_CONVW, I_WOUT, I_MW1, I_MW2, I_FNG };

DI unsigned pack2(float lo, float hi) { f32x2 v = {lo, hi}; return __builtin_bit_cast(unsigned, __builtin_convertvector(v, bf16x2_t)); }
DI float bf2f(u16 b) { return __uint_as_float(((unsigned)b) << 16); }
DI float bflo(unsigned w) { return __uint_as_float(w << 16); }
DI float bfhi(unsigned w) { return __uint_as_float(w & 0xffff0000u); }
DI float wave_sum(float x) {
#pragma unroll
    for (int o = 32; o >= 1; o >>= 1) x += __shfl_xor(x, o);
    return x;
}
DI float dpp_f(float x, const int ctrl_sel) {
    int r;
    if (ctrl_sel == 0) r = __builtin_amdgcn_update_dpp(0, __builtin_bit_cast(int, x), 0xB1, 0xF, 0xF, true);
    else if (ctrl_sel == 1) r = __builtin_amdgcn_update_dpp(0, __builtin_bit_cast(int, x), 0x4E, 0xF, 0xF, true);
    else if (ctrl_sel == 2) r = __builtin_amdgcn_update_dpp(0, __builtin_bit_cast(int, x), 0x141, 0xF, 0xF, true);
    else r = __builtin_amdgcn_update_dpp(0, __builtin_bit_cast(int, x), 0x140, 0xF, 0xF, true);
    return __builtin_bit_cast(float, r);
}
DI float dpp_xor1(float x) { return __builtin_bit_cast(float, __builtin_amdgcn_update_dpp(0, __builtin_bit_cast(int, x), 0xB1, 0xF, 0xF, true)); }
DI float dpp_xor2(float x) { return __builtin_bit_cast(float, __builtin_amdgcn_update_dpp(0, __builtin_bit_cast(int, x), 0x4E, 0xF, 0xF, true)); }
DI float dpp_shl4(float x) { return __builtin_bit_cast(float, __builtin_amdgcn_update_dpp(0, __builtin_bit_cast(int, x), 0x104, 0xF, 0xF, true)); }
DI float dpp_shr4(float x) { return __builtin_bit_cast(float, __builtin_amdgcn_update_dpp(0, __builtin_bit_cast(int, x), 0x114, 0xF, 0xF, true)); }
DI float red8(float x) { x += dpp_f(x, 0); x += dpp_f(x, 1); x += dpp_f(x, 2); return x; }
DI float red16(float x) { x += dpp_f(x, 0); x += dpp_f(x, 1); x += dpp_f(x, 2); x += dpp_f(x, 3); return x; }
template <int N> DI void wsum_n(float (&x)[N]) {
#pragma unroll
    for (int i = 0; i < N; ++i) x[i] += dpp_f(x[i], 0);
#pragma unroll
    for (int i = 0; i < N; ++i) x[i] += dpp_f(x[i], 1);
#pragma unroll
    for (int i = 0; i < N; ++i) x[i] += dpp_f(x[i], 2);
#pragma unroll
    for (int i = 0; i < N; ++i) x[i] += dpp_f(x[i], 3);
#pragma unroll
    for (int i = 0; i < N; ++i) x[i] += __shfl_xor(x[i], 16);
#pragma unroll
    for (int i = 0; i < N; ++i) x[i] += __shfl_xor(x[i], 32);
}
DI int tid_() { int t = threadIdx.x; asm volatile("" : "+v"(t)); return t; }
DI int modrow(int row) { return row < NCT ? 8 : ((row - NCT) >> 11); }
DI float sigmoidf_(float x) { return 1.0f / (1.0f + __expf(-x)); }

namespace pg8 {
typedef u16 bf16_t;
constexpr int BM = 256, BK = 64, HALF = 128, HTB = HALF * BK * 2, STAGE_BYTES = 8 * HTB, NXCD = 8, WGM = 8;
DI int lds_byte(int r, int c) { const int st = (r >> 4) * 2 + (c >> 5), rr = r & 15, cc = c & 31, ob = rr * 64 + cc * 2; return st * 1024 + (ob ^ (((ob >> 9) & 1) << 5)); }
DI void stage_rc(int b, int& R, int& C) { const int st = b / 1024, sb = b % 1024, swz = sb ^ (((sb >> 9) & 1) << 5); R = (st >> 1) * 16 + swz / 64; C = (st & 1) * 32 + (swz % 64) / 2; }
DI int perm32(int rho) { const int n = rho >> 4, i = rho & 15; return 8 * (i >> 2) + 4 * n + (i & 3); }
struct Unit { int pm, pn; };
struct Gemm { const bf16_t* A; const bf16_t* Bt; int M, N, K, lda, ldb; };
struct StaticOrder {
    int nM, nN, nwg, G, c;
    DI void init(int M, int N, int G_, int c_) { nM = M / BM; nN = N / BM; nwg = nM * nN; G = G_; c = c_; }
    DI bool next(int i, Unit& u) const {
        const long L = (long)i * G + c; if (L >= nwg) return false;
        int wgid = (int)L; { const int q = nwg / NXCD, r = nwg % NXCD, xcd = wgid % NXCD, off = wgid / NXCD; wgid = (xcd < r ? xcd * (q + 1) : r * (q + 1) + (xcd - r) * q) + off; }
        const int nig = WGM * nN, gid = wgid / nig, fm = gid * WGM, gsz = (nM - fm) < WGM ? (nM - fm) : WGM;
        u.pm = fm + ((wgid % nig) % gsz); u.pn = (wgid % nig) / gsz; return true;
    }
    DI void a_ready(const Unit&) const {}
    DI void done(const Unit&) const {}
};
DI unsigned cvt_pk_bf16(float lo, float hi) { return pack2(lo, hi); }

template <int ACT> struct EpiBf16 {
    static constexpr bool PERM = true, AFTER_DRAIN = false;
    bf16_t* O; int ldc; int row_off;
    DI void operator()(const f32x4 (&acc)[2][2][4][2], const Unit& u, int wr, int wc, int fr, int fq) const {
        const int row0 = u.pm * BM + row_off + wr * 64 + fr; const int col0 = u.pn * BM + wc * 32 + 8 * fq;
#pragma unroll
        for (int ai = 0; ai < 2; ++ai)
#pragma unroll
            for (int m = 0; m < 4; ++m) { bf16_t* rowp = O + (size_t)(row0 + ai * HALF + m * 16) * ldc + col0;
#pragma unroll
                for (int bj = 0; bj < 2; ++bj) { f32x4 v0 = acc[ai][bj][m][0], v1 = acc[ai][bj][m][1];
                    if (ACT == 3) {
#pragma unroll
                        for (int j = 0; j < 4; ++j) { float a = fmaxf(v0[j], 0.f), b = fmaxf(v1[j], 0.f); v0[j] = a * a; v1[j] = b * b; } }
                    u32x4 w; w.x = cvt_pk_bf16(v0[0], v0[1]); w.y = cvt_pk_bf16(v0[2], v0[3]); w.z = cvt_pk_bf16(v1[0], v1[1]); w.w = cvt_pk_bf16(v1[2], v1[3]);
                    *(u32x4*)(rowp + bj * HALF) = w; } }
    }
};
struct EpiRes {
    static constexpr bool PERM = false, AFTER_DRAIN = false;
    const float* res_c; const float* res_l; float* h_c; float* h_l; const float* gate; int row_off;
    DI void operator()(const f32x4 (&acc)[2][2][4][2], const Unit& u, int wr, int wc, int fr, int fq) const {
        const int rbase = u.pm * BM + row_off; const bool isc = rbase < NCT; const int mr = isc ? 8 : ((rbase - NCT) >> 11);
        const float* rp = isc ? res_c + (size_t)rbase * D : res_l + (size_t)(rbase - NCT) * D;
        float* hp = isc ? h_c + (size_t)rbase * D : h_l + (size_t)(rbase - NCT) * D;
        const float* g = gate + (size_t)mr * (6 * D);
        const int col0 = u.pn * BM + wc * 32 + 4 * fq;
        f32x4 gv[2][2];
#pragma unroll
        for (int bj = 0; bj < 2; ++bj)
#pragma unroll
            for (int n = 0; n < 2; ++n) gv[bj][n] = *(const f32x4*)(g + col0 + bj * HALF + n * 16);
#pragma unroll
        for (int ai = 0; ai < 2; ++ai) {
            f32x4 r[4][2][2];
#pragma unroll
            for (int m = 0; m < 4; ++m) { const size_t ro = (size_t)(wr * 64 + fr + ai * HALF + m * 16) * D + col0;
#pragma unroll
                for (int bj = 0; bj < 2; ++bj)
#pragma unroll
                    for (int n = 0; n < 2; ++n) r[m][bj][n] = *(const f32x4*)(rp + ro + bj * HALF + n * 16); }
            __builtin_amdgcn_sched_barrier(0);
#pragma unroll
            for (int m = 0; m < 4; ++m) { const size_t ro = (size_t)(wr * 64 + fr + ai * HALF + m * 16) * D + col0;
#pragma unroll
                for (int bj = 0; bj < 2; ++bj)
#pragma unroll
                    for (int n = 0; n < 2; ++n) *(f32x4*)(hp + ro + bj * HALF + n * 16) = r[m][bj][n] + gv[bj][n] * acc[ai][bj][m][n]; }
            __builtin_amdgcn_sched_barrier(0);
        }
    }
};
struct EpiResAtomic {
    static constexpr bool PERM = false, AFTER_DRAIN = false;
    float* h_c; const float* gate;
    DI void operator()(const f32x4 (&acc)[2][2][4][2], const Unit& u, int wr, int wc, int fr, int fq) const {
        float* hp = h_c + (size_t)(u.pm * BM) * D;
        const float* g = gate + (size_t)8 * (6 * D);
        const int col0 = u.pn * BM + wc * 32 + 4 * fq;
        f32x4 gv[2][2];
#pragma unroll
        for (int bj = 0; bj < 2; ++bj)
#pragma unroll
            for (int n = 0; n < 2; ++n) gv[bj][n] = *(const f32x4*)(g + col0 + bj * HALF + n * 16);
#pragma unroll
        for (int ai = 0; ai < 2; ++ai)
#pragma unroll
            for (int m = 0; m < 4; ++m) { float* rp = hp + (size_t)(wr * 64 + fr + ai * HALF + m * 16) * D + col0;
#pragma unroll
                for (int bj = 0; bj < 2; ++bj)
#pragma unroll
                    for (int n = 0; n < 2; ++n) { const f32x4 v = gv[bj][n] * acc[ai][bj][m][n];
#pragma unroll
                        for (int j = 0; j < 4; ++j) __hip_atomic_fetch_add(rp + bj * HALF + n * 16 + j, v[j], __ATOMIC_RELAXED, __HIP_MEMORY_SCOPE_AGENT); } }
    }
};
struct EpiQ {
    static constexpr bool PERM = false, AFTER_DRAIN = false;
    bf16_t* Q; const float* rope; int row_off; float qscale;
    DI void operator()(const f32x4 (&acc)[2][2][4][2], const Unit& u, int wr, int wc, int fr, int fq) const {
        const int rbase = u.pm * BM + row_off; const bool isc = rbase < NCT;
#pragma unroll
        for (int ai = 0; ai < 2; ++ai)
#pragma unroll
            for (int m = 0; m < 4; ++m) {
                const int row = rbase + wr * 64 + fr + ai * HALF + m * 16;
                int b, pos, t;
                if (isc) { b = row >> 8; t = row & 255; pos = t; } else { b = (row - NCT) >> 11; t = (row - NCT) & 2047; pos = CTX + t; }
#pragma unroll
                for (int bj = 0; bj < 2; ++bj) {
                    const int c0 = u.pn * BM + bj * HALF + wc * 32;
                    const int hh = c0 / 192, within0 = c0 - hh * 192;
                    f32x4 v0 = acc[ai][bj][m][0] * qscale, v1 = acc[ai][bj][m][1] * qscale;
                    if (within0 >= 128 && !isc) {
                        const int ax = (within0 - 128) >> 5; const int pp = ax ? (t & 63) : (t >> 6);
                        const float* rt = rope + (size_t)(pp * 16 + 4 * fq) * 2;
#pragma unroll
                        for (int j = 0; j < 4; ++j) { const float cs = rt[2 * j], sn = rt[2 * j + 1]; const float x1 = v0[j], x2 = v1[j]; v0[j] = x1 * cs - x2 * sn; v1[j] = x2 * cs + x1 * sn; }
                    }
                    bf16_t* qp = Q + ((size_t)(b * 4 + hh) * KP + pos) * 192 + within0 + 4 * fq;
                    u32x2 w0, w1; w0.x = pack2(v0[0], v0[1]); w0.y = pack2(v0[2], v0[3]); w1.x = pack2(v1[0], v1[1]); w1.y = pack2(v1[2], v1[3]);
                    *(u32x2*)(qp) = w0; *(u32x2*)(qp + 16) = w1;
                }
                __builtin_amdgcn_sched_barrier(0);
            }
    }
};
struct EpiKV {
    static constexpr bool PERM = true, AFTER_DRAIN = false;
    bf16_t* K; bf16_t* VT; int row_off;
    DI void operator()(const f32x4 (&acc)[2][2][4][2], const Unit& u, int wr, int wc, int fr, int fq) const {
        const int rbase = u.pm * BM + row_off; const bool isc = rbase < NCT; const int hh = u.pn;
#pragma unroll
        for (int ai = 0; ai < 2; ++ai)
#pragma unroll
            for (int m = 0; m < 4; ++m) {
                const int row = rbase + wr * 64 + fr + ai * HALF + m * 16;
                int b, pos;
                if (isc) { b = row >> 8; pos = row & 255; } else { b = (row - NCT) >> 11; pos = CTX + ((row - NCT) & 2047); }
                const int d0 = wc * 32 + 8 * fq;
                { const f32x4 v0 = acc[ai][0][m][0], v1 = acc[ai][0][m][1];
                  u32x4 w; w.x = pack2(v0[0], v0[1]); w.y = pack2(v0[2], v0[3]); w.z = pack2(v1[0], v1[1]); w.w = pack2(v1[2], v1[3]);
                  *(u32x4*)(K + ((size_t)(b * 4 + hh) * KP + pos) * 128 + d0) = w; }
                { const f32x4 v0 = acc[ai][1][m][0], v1 = acc[ai][1][m][1];
                  bf16_t* vp = VT + (((size_t)(b * 4 + hh) * (KP / 64) + (pos >> 6)) * 128 + d0) * 64 + (pos & 63);
#pragma unroll
                  for (int j = 0; j < 4; ++j) { vp[j * 64] = (bf16_t)(pack2(v0[j], 0.f) & 0xffffu); vp[(4 + j) * 64] = (bf16_t)(pack2(v1[j], 0.f) & 0xffffu); } }
                __builtin_amdgcn_sched_barrier(0);
            }
    }
};
struct EpiLora {
    static constexpr bool PERM = true, AFTER_DRAIN = false;
    float* DEC; bf16_t* AA; bf16_t* G; const float* w0; const float* a0; int pn_off;
    DI void operator()(const f32x4 (&acc)[2][2][4][2], const Unit& u, int wr, int wc, int fr, int fq) const {
        const int sect = (u.pn + pn_off) >> 1; const int row0 = u.pm * BM + wr * 64 + fr;
#pragma unroll
        for (int bj = 0; bj < 2; ++bj) {
            const int ch = (u.pn & 1) * 256 + bj * HALF + wc * 32 + 8 * fq;
            float bias[8];
            if (sect < 2) {
#pragma unroll
                for (int j = 0; j < 8; ++j) bias[j] = w0[sect * 512 + ch + j];
            } else if (sect < 4) {
#pragma unroll
                for (int j = 0; j < 8; ++j) bias[j] = a0[(sect - 2) * 512 + ch + j];
            } else {
#pragma unroll
                for (int j = 0; j < 8; ++j) bias[j] = 0.f;
            }
#pragma unroll
            for (int ai = 0; ai < 2; ++ai)
#pragma unroll
                for (int m = 0; m < 4; ++m) {
                    const int row = row0 + ai * HALF + m * 16;
                    float v[8];
#pragma unroll
                    for (int j = 0; j < 4; ++j) { v[j] = acc[ai][bj][m][0][j] + bias[j]; v[4 + j] = acc[ai][bj][m][1][j] + bias[4 + j]; }
                    if (sect < 2) {
#pragma unroll
                        for (int j = 0; j < 8; ++j) { const float w = -__logf(1.0f + __expf(-v[j])) - 0.5f; v[j] = __expf(-__expf(w)); }
                        float* dp = DEC + ((size_t)sect * NTOK + row) * 512 + ch;
                        *(f32x4*)dp = (f32x4){v[0], v[1], v[2], v[3]}; *(f32x4*)(dp + 4) = (f32x4){v[4], v[5], v[6], v[7]};
                    } else {
                        if (sect < 4) {
#pragma unroll
                            for (int j = 0; j < 8; ++j) v[j] = sigmoidf_(v[j]);
                        }
                        bf16_t* op = (sect < 4) ? AA + ((size_t)(sect - 2) * NTOK + row) * 512 + ch : G + (size_t)row * 512 + ch;
                        u32x4 w; w.x = pack2(v[0], v[1]); w.y = pack2(v[2], v[3]); w.z = pack2(v[4], v[5]); w.w = pack2(v[6], v[7]);
                        *(u32x4*)op = w;
                    }
                    __builtin_amdgcn_sched_barrier(0);
                }
        }
    }
};

template <class Epi, class Sched>
DI void gemm_phase(LAS unsigned char* lds, const Gemm g, const Sched& S, const Epi& E) {
    const int tid = tid_(), wid = __builtin_amdgcn_readfirstlane(tid >> 6), lane = tid & 63, wr = wid >> 2, wc = wid & 3, fr = lane & 15, fq = lane >> 4;
    const int K = g.K, nt = K / BK;
    unsigned voffA[2], voffB[2];
#pragma unroll
    for (int i = 0; i < 2; ++i) { int R, C; stage_rc(tid * 16 + i * 8192, R, C); const int Rb = Epi::PERM ? ((R & ~31) + perm32(R & 31)) : R;
        voffA[i] = (unsigned)(R * g.lda + C) * 2u; voffB[i] = (unsigned)(Rb * g.ldb + C) * 2u; }
    const size_t kstep = (size_t)(BK * 2);
    const size_t hstepA = (size_t)HALF * g.lda * 2, hstepB = (size_t)HALF * g.ldb * 2;
    const size_t tstepA = 2 * hstepA, tstepB = 2 * hstepB;
    const unsigned ldsw = (unsigned)wid * 1024u;
    const int aoff = lds_byte(wr * 64 + fr, fq * 8), boff = lds_byte(wc * 32 + fr, fq * 8);
#define PG8_SA(b, h) (((b) * 2 + (h)) * HTB)
#define PG8_SB(b, h) ((4 + (b) * 2 + (h)) * HTB)
#define PG8_STAGE(bufoff, gbase, voff) do { _Pragma("unroll") for (int _i = 0; _i < 2; ++_i) \
        __builtin_amdgcn_global_load_lds((const unsigned*)((const char*)(gbase) + (voff)[_i]), (LAS unsigned*)(lds + (bufoff) + ldsw + _i * 8192), 16, 0, 0); } while (0)
#define PG8_LDA(dst, b, h) do { _Pragma("unroll") for (int m = 0; m < 4; ++m) _Pragma("unroll") for (int k = 0; k < 2; ++k) dst[m][k] = *(const LAS bf16x8*)(lds + PG8_SA(b, h) + aoff + m * 2048 + k * 1024); } while (0)
#define PG8_LDB(dst, b, h) do { _Pragma("unroll") for (int n = 0; n < 2; ++n) _Pragma("unroll") for (int k = 0; k < 2; ++k) dst[n][k] = *(const LAS bf16x8*)(lds + PG8_SB(b, h) + boff + n * 2048 + k * 1024); } while (0)
#define PG8_MMA(ai, bj, At, Bt) do { __builtin_amdgcn_s_setprio(1); _Pragma("unroll") for (int m = 0; m < 4; ++m) _Pragma("unroll") for (int n = 0; n < 2; ++n) _Pragma("unroll") for (int k = 0; k < 2; ++k) \
        acc[ai][bj][m][n] = __builtin_amdgcn_mfma_f32_16x16x32_bf16(Bt[n][k], At[m][k], acc[ai][bj][m][n], 0, 0, 0); __builtin_amdgcn_s_setprio(0); } while (0)
#define PG8_WAIT_V(n) asm volatile("s_waitcnt vmcnt(" #n ")" ::: "memory")
#define PG8_WAIT_L(n) asm volatile("s_waitcnt lgkmcnt(" #n ")" ::: "memory")
#define PG8_BAR __builtin_amdgcn_s_barrier()
#define PG8_SCHED __builtin_amdgcn_sched_barrier(0)
    Unit cur, nxt; int ui = 0;
    if (!S.next(0, cur)) return;
    f32x4 acc[2][2][4][2];
#pragma unroll
    for (int a = 0; a < 2; ++a)
#pragma unroll
        for (int b = 0; b < 2; ++b)
#pragma unroll
            for (int m = 0; m < 4; ++m)
#pragma unroll
                for (int n = 0; n < 2; ++n) acc[a][b][m][n] = (f32x4){0.f, 0.f, 0.f, 0.f};
    bf16x8 At[4][2], B0[2][2], B1[2][2];
    const char* cA = (const char*)g.A + (size_t)cur.pm * tstepA; const char* cB = (const char*)g.Bt + (size_t)cur.pn * tstepB;
    S.a_ready(cur);
    PG8_STAGE(PG8_SB(0, 0), cB, voffB); PG8_STAGE(PG8_SA(0, 0), cA, voffA); PG8_STAGE(PG8_SB(0, 1), cB + hstepB, voffB); PG8_STAGE(PG8_SA(0, 1), cA + hstepA, voffA);
    if (wr == 1) PG8_BAR;
    PG8_WAIT_V(4); PG8_BAR;
    PG8_STAGE(PG8_SB(1, 0), cB + kstep, voffB); PG8_STAGE(PG8_SA(1, 0), cA + kstep, voffA); PG8_STAGE(PG8_SB(1, 1), cB + hstepB + kstep, voffB);
    PG8_WAIT_V(6); PG8_BAR;
    for (;;) {
        const bool has_next = S.next(ui + 1, nxt);
        const char* nA = has_next ? (const char*)g.A + (size_t)nxt.pm * tstepA : cA; const char* nB = has_next ? (const char*)g.Bt + (size_t)nxt.pn * tstepB : cB;
#pragma nounroll
        for (int t = 0; t < nt; t += 2) {
            const bool last = (t == nt - 2);
            const char* a1 = cA + (size_t)(t + 1) * kstep;
            const char* a2 = last ? nA : cA + (size_t)(t + 2) * kstep; const char* b2 = last ? nB : cB + (size_t)(t + 2) * kstep;
            const char* a3 = a2 + kstep; const char* b3 = b2 + kstep;
            if (last && has_next) S.a_ready(nxt);
            PG8_LDB(B0, 0, 0); PG8_SCHED; PG8_LDA(At, 0, 0); PG8_STAGE(PG8_SA(1, 1), a1 + hstepA, voffA);
            PG8_WAIT_L(8); PG8_BAR; PG8_WAIT_L(0); PG8_MMA(0, 0, At, B0); PG8_BAR; PG8_SCHED;
            PG8_LDB(B1, 0, 1); PG8_STAGE(PG8_SB(0, 0), b2, voffB);
            PG8_BAR; PG8_WAIT_L(0); PG8_MMA(0, 1, At, B1); PG8_BAR;
            PG8_LDA(At, 0, 1); PG8_STAGE(PG8_SA(0, 0), a2, voffA);
            PG8_BAR; PG8_WAIT_L(0); PG8_MMA(1, 0, At, B0); PG8_BAR; PG8_SCHED;
            PG8_STAGE(PG8_SB(0, 1), b2 + hstepB, voffB);
            PG8_WAIT_V(6); PG8_BAR; PG8_MMA(1, 1, At, B1); PG8_BAR;
            PG8_LDB(B0, 1, 0); PG8_SCHED; PG8_LDA(At, 1, 0); PG8_STAGE(PG8_SA(0, 1), a2 + hstepA, voffA);
            PG8_WAIT_L(8); PG8_BAR; PG8_WAIT_L(0); PG8_MMA(0, 0, At, B0); PG8_BAR; PG8_SCHED;
            PG8_LDB(B1, 1, 1); PG8_STAGE(PG8_SB(1, 0), b3, voffB);
            PG8_BAR; PG8_WAIT_L(0); PG8_MMA(0, 1, At, B1); PG8_BAR;
            PG8_LDA(At, 1, 1); PG8_STAGE(PG8_SA(1, 0), a3, voffA);
            PG8_BAR; PG8_WAIT_L(0); PG8_MMA(1, 0, At, B0); PG8_BAR; PG8_SCHED;
            PG8_STAGE(PG8_SB(1, 1), b3 + hstepB, voffB);
            PG8_WAIT_V(6); PG8_BAR; PG8_MMA(1, 1, At, B1); PG8_BAR;
        }
        { int fr_e = fr, fq_e = fq; asm volatile("" : "+v"(fr_e), "+v"(fq_e)); E(acc, cur, wr, wc, fr_e, fq_e); } S.done(cur);
        __builtin_amdgcn_s_waitcnt(0x0F70);
        if (!has_next) break;
#pragma unroll
        for (int a = 0; a < 2; ++a)
#pragma unroll
            for (int b = 0; b < 2; ++b)
#pragma unroll
                for (int m = 0; m < 4; ++m)
#pragma unroll
                    for (int n = 0; n < 2; ++n) acc[a][b][m][n] = (f32x4){0.f, 0.f, 0.f, 0.f};
        cur = nxt; cA = nA; cB = nB; ++ui;
    }
    PG8_WAIT_V(0);
    if (wr == 0) PG8_BAR;
    PG8_BAR;
#undef PG8_SA
#undef PG8_SB
#undef PG8_STAGE
#undef PG8_LDA
#undef PG8_LDB
#undef PG8_MMA
#undef PG8_WAIT_V
#undef PG8_WAIT_L
#undef PG8_BAR
#undef PG8_SCHED
}
}

template <class Epi>
DI void run_gemm(LAS unsigned char* lds, const u16* A, const u16* Bt, int M, int N, int K, const Epi& E, int rot, int lda = 0, int ldb = 0) {
    asm volatile("" : "+s"(K), "+s"(M), "+s"(N));
    pg8::Gemm g; g.A = A; g.Bt = Bt; g.M = M; g.N = N; g.K = K; g.lda = lda ? lda : K; g.ldb = ldb ? ldb : K;
    pg8::StaticOrder S; S.init(M, N, (int)gridDim.x, (int)((blockIdx.x + (unsigned)rot) % gridDim.x));
    pg8::gemm_phase<Epi, pg8::StaticOrder>(lds, g, S, E);
}

DI void conv_T(LAS unsigned char* lds, const float* src, int ld_src, int K, int N, u16* dst, int ld_dst, const float* colscale, int rot, int nwk = 0, int wk = 0) {
    LAS float* T = (LAS float*)lds;
    const int tid = tid_();
    const int nkt = (K + 63) >> 6, nng = (N + 255) >> 8, nitem = nkt * nng;
    const int t_step = nwk ? nwk : (int)gridDim.x; const int t_first = nwk ? wk : (int)((blockIdx.x + (unsigned)rot) % gridDim.x);
    for (int t = t_first; t < nitem; t += t_step) {
        const int kt = t / nng, ng = t - kt * nng; const int k0 = kt * 64, n0 = ng * 256;
        { const int kk = tid >> 4, n4 = (tid & 15) * 4;
          f32x4 v[4][2];
#pragma unroll
          for (int j = 0; j < 4; ++j)
#pragma unroll
              for (int ps = 0; ps < 2; ++ps) { const int k = k0 + kk + 32 * ps; v[j][ps] = (f32x4){0.f, 0.f, 0.f, 0.f};
                  if (k < K && n0 + 64 * j < N) v[j][ps] = *(const f32x4*)(src + (size_t)k * ld_src + n0 + 64 * j + n4); }
#pragma unroll
          for (int j = 0; j < 4; ++j)
#pragma unroll
              for (int ps = 0; ps < 2; ++ps) { LAS float* tp = T + j * (64 * 65) + (kk + 32 * ps) * 65 + n4; tp[0] = v[j][ps][0]; tp[1] = v[j][ps][1]; tp[2] = v[j][ps][2]; tp[3] = v[j][ps][3]; } }
        __syncthreads();
        { const int n = tid >> 3, k8 = (tid & 7) * 8;
          if (k0 + k8 < K) {
#pragma unroll
              for (int j = 0; j < 4; ++j) {
                  if (n0 + 64 * j < N) { const int nn = n0 + 64 * j + n; const float sc = colscale ? colscale[nn] : 1.0f; float v[8];
#pragma unroll
                      for (int i = 0; i < 8; ++i) v[i] = T[j * (64 * 65) + (k8 + i) * 65 + n] * sc;
                      u32x4 w; w.x = pack2(v[0], v[1]); w.y = pack2(v[2], v[3]); w.z = pack2(v[4], v[5]); w.w = pack2(v[6], v[7]);
                      *(u32x4*)(dst + (size_t)nn * ld_dst + k0 + k8) = w; } } } }
        __syncthreads();
    }
}
DI void conv_big(PP p, LAS unsigned char* lds, int l, int which, int nwk = 0, int wk = 0) {
    unsigned char* ws = p->ws;
    if (which == 0) conv_T(lds, p->in[I_WIN] + (size_t)l * 2048 * 4800, 4800, 2048, 4800, (u16*)(ws + OFF_WIN), 2048, nullptr, 0);
    else if (which == 1) conv_T(lds, p->in[I_WOUT] + (size_t)l * 2048 * 2048, 2048, 2048, 2048, (u16*)(ws + OFF_WOUT), 2048, nullptr, 96, nwk, wk);
    else if (which == 2) conv_T(lds, p->in[I_MW1] + (size_t)l * 2048 * FF, FF, 2048, FF, (u16*)(ws + OFF_W1), 2048, nullptr, 0, nwk, wk);
    else conv_T(lds, p->in[I_MW2] + (size_t)l * FF * 2048, 2048, FF, 2048, (u16*)(ws + OFF_W2), FFP, nullptr, 0, nwk, wk);
}
DI void conv_small(PP p, LAS unsigned char* lds, int l) {
    unsigned char* base = p->ws + OFF_SMALL + (size_t)l * SZ_SMALL;
    u16* uq = (u16*)base; u16* ukv = (u16*)(base + SZ_UQ); u16* lora = (u16*)(base + SZ_UQ + SZ_UKV); u16* pw = (u16*)(base + SZ_UQ + SZ_UKV + SZ_LORA);
    conv_T(lds, p->in[I_WUQ] + (size_t)l * 384 * 768, 768, 384, 768, uq, 384, nullptr, 0);
    conv_T(lds, p->in[I_WUKV] + (size_t)l * 128 * 1024, 1024, 128, 1024, ukv, 256, nullptr, 72);
    for (int d = 0; d < 2; ++d) {
        conv_T(lds, p->in[I_W2] + (size_t)(l * 2 + d) * 96 * 512, 512, 96, 512, lora + (size_t)(d * 512) * 640 + d * 96, 640, nullptr, 104 + 16 * d);
        conv_T(lds, p->in[I_A2] + (size_t)(l * 2 + d) * 96 * 512, 512, 96, 512, lora + (size_t)(1024 + d * 512) * 640 + 192 + d * 96, 640, nullptr, 136 + 16 * d);
    }
    conv_T(lds, p->in[I_G2] + (size_t)l * 256 * 512, 512, 256, 512, lora + (size_t)2048 * 640 + 384, 640, nullptr, 168);
    for (int g = 0; g < 4; ++g)
        conv_T(lds, p->in[I_POOLW] + (size_t)(l * 4 + g) * 128 * 128, 128, 128, 128, pw + (size_t)(g * 128) * 512 + g * 128, 512, p->in[I_POOLS] + l * 512 + g * 128, 200 + 4 * g);
}

DI void mod_phase(PP p, LAS unsigned char* lds) {
    LAS float* sc = (LAS float*)lds;
    LAS float* red = sc + 9 * 2048;
    const int tid = tid_(), wid = tid >> 6, lane = tid & 63;
    {
#pragma unroll
        for (int i0 = 0; i0 < 36; i0 += 12) { float v[12];
#pragma unroll
            for (int u = 0; u < 12; ++u) { const int i = tid + (i0 + u) * 512; const int m = i >> 11, k = i & 2047; v[u] = (m < 8) ? p->in[I_C][m * 2048 + k] : p->in[I_CCTX][k]; }
#pragma unroll
            for (int u = 0; u < 12; ++u) sc[tid + (i0 + u) * 512] = v[u] / (1.0f + __expf(-v[u])); }
    }
    __syncthreads();
    float* MOD = (float*)(p->ws + OFF_MOD);
    for (int item = blockIdx.x; item < 2 * 192 * 2; item += gridDim.x) {
        const int kh = item & 1, it2 = item >> 1; const int l = it2 / 192, j0 = (it2 - l * 192) * 64;
        const int kb = kh * 1024 + wid * 128;
        const float* W = p->in[I_ADAW] + (size_t)l * 2048 * 12288 + (size_t)kb * 12288 + j0 + lane;
        float acc[9];
#pragma unroll
        for (int m = 0; m < 9; ++m) acc[m] = 0.f;
#pragma nounroll
        for (int k = 0; k < 128; k += 16) {
            float wv[16];
#pragma unroll
            for (int i = 0; i < 16; ++i) wv[i] = W[(size_t)(k + i) * 12288];
#pragma unroll
            for (int m = 0; m < 9; ++m) {
#pragma unroll
                for (int i4 = 0; i4 < 4; ++i4) { const f32x4 sv = *(const LAS f32x4*)(sc + m * 2048 + kb + k + 4 * i4);
                    acc[m] += sv[0] * wv[4 * i4] + sv[1] * wv[4 * i4 + 1] + sv[2] * wv[4 * i4 + 2] + sv[3] * wv[4 * i4 + 3]; } }
        }
#pragma unroll
        for (int m = 0; m < 9; ++m) red[(wid * 9 + m) * 64 + lane] = acc[m];
        __syncthreads();
        for (int i = tid; i < 9 * 64; i += 512) { const int m = i >> 6, ln = i & 63; float sm = 0.f;
#pragma unroll
            for (int w = 0; w < 8; ++w) sm += red[(w * 9 + m) * 64 + ln];
            if (kh == 0) sm += p->in[I_ADAB][l * 12288 + j0 + ln];
            __hip_atomic_fetch_add(MOD + ((size_t)l * 9 + m) * 12288 + j0 + ln, sm, __ATOMIC_RELAXED, __HIP_MEMORY_SCOPE_AGENT); }
        __syncthreads();
    }
    if (blockIdx.x == gridDim.x - 1) {
        float* RT = (float*)(p->ws + OFF_ROPE);
        for (int i = tid; i < 1024; i += 512) { const int pp = i >> 4, f = i & 15;
            const float inv = __builtin_amdgcn_exp2f(-(float)f * (13.287712379549449f / 16.0f));
            const float x = (float)pp * inv;
            const float n = rintf(x * 0.15915494309189535f);
            float r = fmaf(-n, 6.28318548202514648f, x); r = fmaf(-n, -1.7484555e-7f, r);
            RT[2 * i] = __cosf(r); RT[2 * i + 1] = __sinf(r); }
    }
}

DI void norm_phase(PP p, int l, int which  , int row_lo) {
    const int tid = tid_(); const int wid = tid >> 6, lane = tid & 63;
    const int gw = blockIdx.x * 8 + wid, nw = gridDim.x * 8;
    const float* gsrc = which == 0 ? p->in[I_N1G] + l * D : (which == 1 ? p->in[I_N2G] + l * D : p->in[I_FNG]);
    const float* MOD = (const float*)(p->ws + OFF_MOD) + (size_t)l * 9 * 12288;
    u16* ACT = (u16*)(p->ws + OFF_ACT);
    float* HC = (float*)(p->ws + OFF_HCTX);
    const bool from_input = (which == 0 && l == 0);
    const int nrows = NTOK - row_lo, per = (nrows + nw - 1) / nw;
    f32x4 g[8], gm[8], sh[8];
#pragma unroll
    for (int i = 0; i < 8; ++i) { g[i] = *(const f32x4*)(gsrc + i * 256 + lane * 4); gm[i] = g[i]; sh[i] = (f32x4){0.f, 0.f, 0.f, 0.f}; }
    int cur_mr = -1;
    for (int k = 0; k < per; ++k) {
        const int row = row_lo + gw * per + k;
        if (row >= NTOK) break;
        const float* hr;
        if (row < NCT) hr = (from_input ? p->in[I_CTX] : HC) + (size_t)row * D;
        else hr = (from_input ? p->in[I_X] : p->out) + (size_t)(row - NCT) * D;
        f32x4 v[8]; float ss = 0.f;
#pragma unroll
        for (int i = 0; i < 8; ++i) v[i] = *(const f32x4*)(hr + i * 256 + lane * 4);
        if (which != 2) { const int mrw = modrow(row);
            if (mrw != cur_mr) { cur_mr = mrw; const float* mr = MOD + (size_t)mrw * 12288 + (which == 0 ? 0 : 3 * D);
#pragma unroll
                for (int i = 0; i < 8; ++i) { const int c = i * 256 + lane * 4; sh[i] = *(const f32x4*)(mr + c); gm[i] = g[i] * (*(const f32x4*)(mr + D + c) + 1.0f); } } }
#pragma unroll
        for (int i = 0; i < 8; ++i) ss += v[i][0] * v[i][0] + v[i][1] * v[i][1] + v[i][2] * v[i][2] + v[i][3] * v[i][3];
        ss = wave_sum(ss);
        const float rstd = rsqrtf(ss * (1.0f / D) + 1e-6f);
        if (which == 2) {
            float* orow = p->out + (size_t)(row - NCT) * D;
#pragma unroll
            for (int i = 0; i < 8; ++i) *(f32x4*)(orow + i * 256 + lane * 4) = v[i] * rstd * g[i];
        } else {
#pragma unroll
            for (int i = 0; i < 8; ++i) { const int c = i * 256 + lane * 4;
                const f32x4 o = v[i] * rstd * gm[i] + sh[i]; u32x2 w; w.x = pack2(o[0], o[1]); w.y = pack2(o[2], o[3]);
                *(u32x2*)(ACT + (size_t)row * D + c) = w; }
        }
    }
}

DI void row_seq(int row, int& t, int& n) { if (row < NCT) { t = row & 255; n = CTX; } else { t = (row - NCT) & 2047; n = SEQ; } }
DI void ld8(const u16* ptr, float (&o)[8]) { const u32x4 w = *(const u32x4*)ptr; o[0] = bflo(w.x); o[1] = bfhi(w.x); o[2] = bflo(w.y); o[3] = bfhi(w.y); o[4] = bflo(w.z); o[5] = bfhi(w.z); o[6] = bflo(w.w); o[7] = bfhi(w.w); }
DI void st8(u16* ptr, const float (&v)[8]) { u32x4 w; w.x = pack2(v[0], v[1]); w.y = pack2(v[2], v[3]); w.z = pack2(v[4], v[5]); w.w = pack2(v[6], v[7]); *(u32x4*)ptr = w; }
DI void prep_phase(PP p, int l) {
    const u16* F = (const u16*)(p->ws + X_F);
    const int tid = tid_(), wid = tid >> 6, lane = tid & 63;
    {
        u16* AQ = (u16*)(p->ws + OFF_AQ); u16* AKV = (u16*)(p->ws + OFF_AKV); u16* KPE = (u16*)(p->ws + OFF_KPE);
        const float* gq = p->in[I_QNG] + l * 384; const float* gkv = p->in[I_KVNG] + l * 128; const float* RT = (const float*)(p->ws + OFF_ROPE);
        float gqv[6], gkv0 = gkv[lane * 2], gkv1 = gkv[lane * 2 + 1];
#pragma unroll
        for (int i = 0; i < 6; ++i) gqv[i] = gq[lane * 6 + i];
        constexpr int NR = 3;
        for (int row0 = (blockIdx.x * 8 + wid) * NR; row0 < NTOK; row0 += gridDim.x * 8 * NR) {
            unsigned qa[NR], qb[NR], qc[NR], kvw[NR]; u16 krw[NR];
#pragma unroll
            for (int r = 0; r < NR; ++r) { const u16* fr = F + (size_t)(row0 + r) * FN; const unsigned* qp = (const unsigned*)(fr + lane * 6);
                qa[r] = qp[0]; qb[r] = qp[1]; qc[r] = qp[2]; kvw[r] = *(const unsigned*)(fr + C_KV + lane * 2); krw[r] = fr[C_KR + lane]; }
            float ssq[NR], ssk[NR];
#pragma unroll
            for (int r = 0; r < NR; ++r) { ssq[r] = bflo(qa[r]) * bflo(qa[r]) + bfhi(qa[r]) * bfhi(qa[r]) + bflo(qb[r]) * bflo(qb[r]) + bfhi(qb[r]) * bfhi(qb[r]) + bflo(qc[r]) * bflo(qc[r]) + bfhi(qc[r]) * bfhi(qc[r]);
                ssk[r] = bflo(kvw[r]) * bflo(kvw[r]) + bfhi(kvw[r]) * bfhi(kvw[r]); }
            wsum_n<NR>(ssq); wsum_n<NR>(ssk);
#pragma unroll
            for (int r = 0; r < NR; ++r) {
                const int row = row0 + r;
                const float rq = rsqrtf(ssq[r] * (1.0f / 384.0f) + 1e-6f), rk = rsqrtf(ssk[r] * (1.0f / 128.0f) + 1e-6f);
                unsigned* op = (unsigned*)(AQ + (size_t)row * 384 + lane * 6);
                op[0] = pack2(bflo(qa[r]) * rq * gqv[0], bfhi(qa[r]) * rq * gqv[1]); op[1] = pack2(bflo(qb[r]) * rq * gqv[2], bfhi(qb[r]) * rq * gqv[3]); op[2] = pack2(bflo(qc[r]) * rq * gqv[4], bfhi(qc[r]) * rq * gqv[5]);
                unsigned* ok = (unsigned*)(AKV + (size_t)row * 256); ok[lane] = pack2(bflo(kvw[r]) * rk * gkv0, bfhi(kvw[r]) * rk * gkv1); ok[64 + lane] = 0u;
                float x = bf2f(krw[r]);
                if (row >= NCT) {
                    const int t = (row - NCT) & 2047;
                    const float pr = __shfl_xor(x, 16);
                    const int ax = lane >> 5, jj = lane & 31, f = jj & 15; const int pp = ax ? (t & 63) : (t >> 6);
                    const float cs = RT[(pp * 16 + f) * 2], sn = RT[(pp * 16 + f) * 2 + 1];
                    x = (jj >> 4) ? (x * cs + pr * sn) : (x * cs - pr * sn);
                }
                KPE[(size_t)row * 64 + lane] = (u16)(pack2(x, 0.f) & 0xffffu);
            }
        }
    }
    const size_t gtid = (size_t)blockIdx.x * 512 + tid, gstride = (size_t)gridDim.x * 512;
    {
        u16* RKV = (u16*)(p->ws + OFF_RKV); u16* AL = (u16*)(p->ws + OFF_ALORA); const float* mu = p->in[I_MU] + l * 2176;
        const int nthr = (int)gstride, ncolw = nthr / 272;
        const int ch = (int)(gtid % 272), run_first = (int)(gtid / 272); const int cc = ch * 8;
        float m8[8];
#pragma unroll
        for (int j = 0; j < 8; ++j) m8[j] = mu[cc + j];
        for (int run = run_first; run < NTOK / 8 && run_first < ncolw; run += ncolw) {
            const int row0 = run * 8;
            int t, n; row_seq(row0, t, n);
            const u16* fp = F + (size_t)row0 * FN + C_RW + cc;
            u32x4 raw[10];
#pragma unroll
            for (int i = 0; i < 8; ++i) raw[i + 1] = *(const u32x4*)(fp + (size_t)i * FN);
            raw[0] = (t > 0) ? *(const u32x4*)(fp - FN) : (u32x4){0u, 0u, 0u, 0u};
            raw[9] = (t + 8 < n) ? *(const u32x4*)(fp + (size_t)8 * FN) : (u32x4){0u, 0u, 0u, 0u};
#pragma unroll
            for (int i = 0; i < 8; ++i) {
                const int row = row0 + i;
                const u32x4 pw = raw[i], cw_ = raw[i + 1], nw = raw[i + 2];
                float f[8];
#pragma unroll
                for (int j = 0; j < 4; ++j) {
                    const unsigned pj = j == 0 ? pw.x : (j == 1 ? pw.y : (j == 2 ? pw.z : pw.w));
                    const unsigned cj = j == 0 ? cw_.x : (j == 1 ? cw_.y : (j == 2 ? cw_.z : cw_.w));
                    const unsigned nj = j == 0 ? nw.x : (j == 1 ? nw.y : (j == 2 ? nw.z : nw.w));
                    const float c0 = bflo(cj), c1 = bfhi(cj);
                    f[2 * j] = c0 + m8[2 * j] * (0.5f * (bflo(pj) + bflo(nj)) - c0);
                    f[2 * j + 1] = c1 + m8[2 * j + 1] * (0.5f * (bfhi(pj) + bfhi(nj)) - c1);
                }
                if (cc < 1536) {
                    const int which = cc >> 9, c = cc & 511;
                    st8(RKV + ((size_t)which * NTOK + row) * 512 + c, f);
                } else {
                    const int c = cc - 1536;
                    if (c < 192) {
#pragma unroll
                        for (int j = 0; j < 8; ++j) { const float e = __expf(2.0f * f[j]); f[j] = 1.0f - 2.0f / (e + 1.0f); }
                    } else if (c >= 384) {
#pragma unroll
                        for (int j = 0; j < 8; ++j) f[j] = sigmoidf_(f[j]);
                    }
                    st8(AL + (size_t)row * 640 + c, f);
                }
            }
        }
    }
    {
        u16* AP = (u16*)(p->ws + OFF_APOOL);
        for (size_t idx = gtid; idx < (size_t)NTOK * 64; idx += gstride) {
            const int g = (int)(idx / ((size_t)NTOK * 16)); const int rem = (int)(idx - (size_t)g * NTOK * 16);
            const int row = rem >> 4, ch = g * 16 + (rem & 15);
            int t, n; row_seq(row, t, n);
            const u16* fp = F + (size_t)row * FN + C_POOL + ch * 8;
            float s[8];
#pragma unroll
            for (int j = 0; j < 8; ++j) s[j] = 0.f;
            const u32x4 uc = *(const u32x4*)fp;
            int cnt;
#define POOL_WIN(HW) do { u32x4 rw[2 * (HW)]; cnt = 0; \
                _Pragma("unroll") for (int i = 0; i < 2 * (HW); ++i) { const int tt = t - (HW) + i; const bool ok = tt >= 0 && tt < n; cnt += ok ? 1 : 0; \
                    rw[i] = ok ? *(const u32x4*)(fp + (ptrdiff_t)(i - (HW)) * FN) : (u32x4){0u, 0u, 0u, 0u}; } \
                _Pragma("unroll") for (int i = 0; i < 2 * (HW); ++i) { s[0] += bflo(rw[i].x); s[1] += bfhi(rw[i].x); s[2] += bflo(rw[i].y); s[3] += bfhi(rw[i].y); \
                    s[4] += bflo(rw[i].z); s[5] += bfhi(rw[i].z); s[6] += bflo(rw[i].w); s[7] += bfhi(rw[i].w); } } while (0)
            if (g == 0) POOL_WIN(1); else if (g == 1) POOL_WIN(2); else if (g == 2) POOL_WIN(4); else POOL_WIN(8);
#undef POOL_WIN
            const float ic = 1.0f / (float)cnt;
            const float u[8] = {bflo(uc.x), bfhi(uc.x), bflo(uc.y), bfhi(uc.y), bflo(uc.z), bfhi(uc.z), bflo(uc.w), bfhi(uc.w)};
#pragma unroll
            for (int j = 0; j < 8; ++j) s[j] = s[j] * ic - u[j];
            st8(AP + (size_t)row * 512 + ch * 8, s);
        }
    }
    {
        u16* ACT = (u16*)(p->ws + OFF_ACT); const float* cw = p->in[I_CONVW] + l * 3 * 512;
        const int ch4 = (int)(gtid & 63), c = ch4 * 8;
        float w0[8], w1[8], w2[8];
#pragma unroll
        for (int j = 0; j < 8; ++j) { w0[j] = cw[c + j]; w1[j] = cw[512 + c + j]; w2[j] = cw[1024 + c + j]; }
        for (size_t idx = gtid; idx < (size_t)(NTOK / 4) * 64; idx += gstride) {
            const int run = (int)(idx >> 6); const int row0 = run * 4;
            int t, n; row_seq(row0, t, n);
            const u16* fp = F + (size_t)row0 * FN;
            u32x4 gcr[6], hxr[6], gbr[4];
#pragma unroll
            for (int i = 0; i < 4; ++i) { gcr[i + 1] = *(const u32x4*)(fp + (size_t)i * FN + C_GC + c); hxr[i + 1] = *(const u32x4*)(fp + (size_t)i * FN + C_HX + c); gbr[i] = *(const u32x4*)(fp + (size_t)i * FN + C_GB + c); }
            const bool hp = t > 0, hn = (t + 4 < n);
            gcr[0] = hp ? *(const u32x4*)(fp - FN + C_GC + c) : (u32x4){0u, 0u, 0u, 0u}; hxr[0] = hp ? *(const u32x4*)(fp - FN + C_HX + c) : (u32x4){0u, 0u, 0u, 0u};
            gcr[5] = hn ? *(const u32x4*)(fp + (size_t)4 * FN + C_GC + c) : (u32x4){0u, 0u, 0u, 0u}; hxr[5] = hn ? *(const u32x4*)(fp + (size_t)4 * FN + C_HX + c) : (u32x4){0u, 0u, 0u, 0u};
            float u[6][8];
#pragma unroll
            for (int i = 0; i < 6; ++i) {
                const unsigned gw[4] = {gcr[i].x, gcr[i].y, gcr[i].z, gcr[i].w}; const unsigned hw_[4] = {hxr[i].x, hxr[i].y, hxr[i].z, hxr[i].w};
#pragma unroll
                for (int j = 0; j < 4; ++j) { u[i][2 * j] = bflo(gw[j]) * bflo(hw_[j]); u[i][2 * j + 1] = bfhi(gw[j]) * bfhi(hw_[j]); }
            }
#pragma unroll
            for (int i = 0; i < 4; ++i) {
                const unsigned bw[4] = {gbr[i].x, gbr[i].y, gbr[i].z, gbr[i].w};
                float z[8];
#pragma unroll
                for (int j = 0; j < 8; ++j) { const float gb = (j & 1) ? bfhi(bw[j >> 1]) : bflo(bw[j >> 1]); z[j] = gb * (w0[j] * u[i][j] + w1[j] * u[i + 1][j] + w2[j] * u[i + 2][j]); }
                st8(ACT + (size_t)(row0 + i) * D + 1536 + c, z);
            }
        }
    }
}

DI int steprow(int b, int dir, int s) {
    if (s < CTX) return b * CTX + (dir ? (CTX - 1 - s) : s);
    const int t = s - CTX; return NCT + b * SEQ + (dir ? (SEQ - 1 - t) : t);
}
DI void scan_item(PP p, int l, int item, LAS unsigned char* lds) {
    const int sid = item >> 1, half = item & 1; const int b = sid >> 4, h = (sid >> 1) & 7, dir = sid & 1;
    const int tid = tid_(), wid = __builtin_amdgcn_readfirstlane(tid >> 6), lane = tid & 63;
    LAS float* buf = (LAS float*)lds;
    const u16* RKV = (const u16*)(p->ws + OFF_RKV);
    const float* DEC = (const float*)(p->ws + X_DEC) + (size_t)dir * NTOK * 512;
    const u16* AA = (const u16*)(p->ws + X_AA) + (size_t)dir * NTOK * 512;
    u16* Y = (u16*)(p->ws + X_Y) + (size_t)dir * NTOK * 512;
    const int ch = h * 64 + lane;
    const float kkw = p->in[I_KK][l * 512 + ch], kaw = p->in[I_KA][l * 512 + ch];
    constexpr int T = 32, NCH = KP / T;
    float pr_[8], pk_[8], pv_[8], pd_[8], pa_[8];
    auto gl = [&](int c) {
        const int pw = wid - 4;
        const int row0 = steprow(b, dir, c * T + pw * 8); const int rs = dir ? -1 : 1;
#pragma unroll
        for (int i = 0; i < 8; ++i) { const size_t o = (size_t)(row0 + rs * i) * 512 + ch;
            pr_[i] = bf2f(RKV[o]); pk_[i] = bf2f(RKV[(size_t)NTOK * 512 + o]); pv_[i] = bf2f(RKV[(size_t)2 * NTOK * 512 + o]); pd_[i] = DEC[o]; pa_[i] = bf2f(AA[o]); }
    };
    auto fill = [&](int c) {
        const int pw = wid - 4;
        float kk[8], n2[8];
#pragma unroll
        for (int i = 0; i < 8; ++i) { kk[i] = pk_[i] * kkw; n2[i] = kk[i] * kk[i]; }
#pragma unroll
        for (int i = 0; i < 8; ++i) n2[i] += dpp_f(n2[i], 0);
#pragma unroll
        for (int i = 0; i < 8; ++i) n2[i] += dpp_f(n2[i], 1);
#pragma unroll
        for (int i = 0; i < 8; ++i) n2[i] += dpp_f(n2[i], 2);
#pragma unroll
        for (int i = 0; i < 8; ++i) n2[i] += dpp_f(n2[i], 3);
#pragma unroll
        for (int i = 0; i < 8; ++i) n2[i] += __shfl_xor(n2[i], 16);
#pragma unroll
        for (int i = 0; i < 8; ++i) n2[i] += __shfl_xor(n2[i], 32);
#pragma unroll
        for (int i = 0; i < 8; ++i) {
            const float kn = kk[i] * __builtin_amdgcn_rsqf(fmaxf(n2[i], 1e-24f));
            LAS float* d = buf + ((c & 1) * T + pw * 8 + i) * 384 + lane;
            d[0] = pr_[i]; d[64] = pd_[i]; d[128] = pk_[i] * (1.0f + (pa_[i] - 1.0f) * kaw); d[192] = -kn; d[256] = kn * pa_[i]; d[320] = pv_[i];
        }
    };
    f32x2 S[4];
#pragma unroll
    for (int j = 0; j < 4; ++j) S[j] = (f32x2){0.f, 0.f};
    const int ks = lane & 7, vrow = half * 32 + (wid & 3) * 8 + (lane >> 3);
    u16* Yp = Y + h * 64 + vrow;
    LAS float* ypl = (LAS float*)(lds + 98304) + (wid & 3) * (8 * 68) + lane;
    __syncthreads();
    if (wid >= 4) { gl(0); fill(0); gl(1); }
    __syncthreads();
#define SC_LD(X, sp_) do { const LAS float* q_ = (sp_) + ks * 8; X##r0 = *(const LAS f32x4*)(q_); X##r1 = *(const LAS f32x4*)(q_ + 4); X##w0 = *(const LAS f32x4*)(q_ + 64); X##w1 = *(const LAS f32x4*)(q_ + 68); \
        X##k0 = *(const LAS f32x4*)(q_ + 128); X##k1 = *(const LAS f32x4*)(q_ + 132); X##a0 = *(const LAS f32x4*)(q_ + 192); X##a1 = *(const LAS f32x4*)(q_ + 196); \
        X##b0 = *(const LAS f32x4*)(q_ + 256); X##b1 = *(const LAS f32x4*)(q_ + 260); X##vv = (sp_)[320 + vrow]; } while (0)
#define SC_STEP(X, srow_) do { \
        f32x2 pa = S[0] * LO2(X##a0); pa = __builtin_elementwise_fma(S[1], HI2(X##a0), pa); f32x2 qa = S[2] * LO2(X##a1); qa = __builtin_elementwise_fma(S[3], HI2(X##a1), qa); pa += qa; \
        float sa = red8(pa[0] + pa[1]); const f32x2 vv2 = {X##vv, X##vv}; \
        f32x2 u0 = __builtin_elementwise_fma(vv2, LO2(X##k0), S[0] * LO2(X##w0)), u1 = __builtin_elementwise_fma(vv2, HI2(X##k0), S[1] * HI2(X##w0)); \
        f32x2 u2 = __builtin_elementwise_fma(vv2, LO2(X##k1), S[2] * LO2(X##w1)), u3 = __builtin_elementwise_fma(vv2, HI2(X##k1), S[3] * HI2(X##w1)); \
        const f32x2 sa2 = {sa, sa}; \
        S[0] = __builtin_elementwise_fma(sa2, LO2(X##b0), u0); S[1] = __builtin_elementwise_fma(sa2, HI2(X##b0), u1); S[2] = __builtin_elementwise_fma(sa2, LO2(X##b1), u2); S[3] = __builtin_elementwise_fma(sa2, HI2(X##b1), u3); \
        f32x2 py = S[0] * LO2(X##r0); py = __builtin_elementwise_fma(S[1], HI2(X##r0), py); f32x2 qy = S[2] * LO2(X##r1); qy = __builtin_elementwise_fma(S[3], HI2(X##r1), qy); py += qy; \
        ypl[((srow_) & 7) * 68] = py[0] + py[1]; } while (0)
#define LO2(v) __builtin_shufflevector(v, v, 0, 1)
#define HI2(v) __builtin_shufflevector(v, v, 2, 3)
    for (int c = 0; c < NCH; ++c) {
        if (wid >= 4) { if (c + 1 < NCH) { fill(c + 1); if (c + 2 < NCH) gl(c + 2); } }
        else {
            const LAS float* sp = buf + ((c & 1) * T) * 384;
            f32x4 Ar0, Ar1, Aw0, Aw1, Ak0, Ak1, Aa0, Aa1, Ab0, Ab1; float Avv;
            f32x4 Br0, Br1, Bw0, Bw1, Bk0, Bk1, Ba0, Ba1, Bb0, Bb1; float Bvv;
            SC_LD(A, sp);
            const ptrdiff_t ystep = dir ? -512 : 512;
            u16* Yl = Yp + (size_t)steprow(b, dir, c * T) * 512 + (ptrdiff_t)ks * ystep;
#pragma nounroll
            for (int st = 0; st < T; st += 2) {
                SC_LD(B, sp + (st + 1) * 384);
                SC_STEP(A, st);
                if (st + 2 < T) SC_LD(A, sp + (st + 2) * 384);
                SC_STEP(B, st + 1);
                if ((st & 6) == 6) {
                    const LAS float* rp = ypl + (ks * 68 - lane) + (lane & ~7);
                    const f32x4 q0 = *(const LAS f32x4*)rp, q1 = *(const LAS f32x4*)(rp + 4);
                    Yl[(ptrdiff_t)(st - 6) * ystep] = (u16)(pack2(((q0[0] + q0[1]) + (q0[2] + q0[3])) + ((q1[0] + q1[1]) + (q1[2] + q1[3])), 0.f) & 0xffffu);
                }
            }
        }
        __syncthreads();
    }
#undef SC_LD
#undef SC_STEP
#undef LO2
#undef HI2
}

constexpr int AT_KROW = 400, AT_KSZ = 64 * AT_KROW, AT_VROW = 136, AT_VSZ = 128 * AT_VROW, AT_BUF = AT_KSZ + AT_VSZ;
DI void attn_unit(PP p, int b, int h, int qpos0, int nk, int orow0, LAS unsigned char* lds) {
    const int tid = tid_(), wid = tid >> 6, lane = tid & 63, ql = lane & 31, g = lane >> 5;
    const u16* Qb = (const u16*)(p->ws + X_Q) + ((size_t)(b * 4 + h) * KP + qpos0 + wid * 32 + ql) * 192;
    const u16* Kb = (const u16*)(p->ws + X_K) + (size_t)(b * 4 + h) * KP * 128;
    const u16* KPEb = (const u16*)(p->ws + OFF_KPE);
    const u16* Vb = (const u16*)(p->ws + X_VT) + (size_t)(b * 4 + h) * 128 * KP;
    bf16x8 qf[12];
#pragma unroll
    for (int s = 0; s < 12; ++s) qf[s] = *(const bf16x8*)(Qb + 16 * s + 8 * g);
    f32x16 o[4];
#pragma unroll
    for (int i = 0; i < 4; ++i)
#pragma unroll
        for (int j = 0; j < 16; ++j) o[i][j] = 0.f;
    float mrun = -__builtin_inff(), lsum = 0.f;
    u32x4 kreg[3], vreg[2];
    const int srow = tid >> 3, sc8 = tid & 7;
    const u16* kgp = Kb + (size_t)srow * 128 + sc8 * 8;
    const u16* pgp = KPEb + (size_t)srow * 64 + sc8 * 8;
    const u16* vgp = Vb + (size_t)srow * 64 + sc8 * 8;
    const int klo = srow * AT_KROW + sc8 * 16, vlo = AT_KSZ + srow * AT_VROW + sc8 * 16;
    auto gload = [&](int t) {
        const int key0 = t * 64;
#pragma unroll
        for (int i = 0; i < 2; ++i) kreg[i] = *(const u32x4*)(kgp + (size_t)key0 * 128 + i * 64);
        { const int rb = key0 < CTX ? b * CTX + key0 : NCT + b * SEQ + key0 - CTX; kreg[2] = *(const u32x4*)(pgp + (size_t)rb * 64); }
#pragma unroll
        for (int i = 0; i < 2; ++i) vreg[i] = *(const u32x4*)(vgp + (size_t)key0 * 128 + i * 64 * 64);
    };
    auto lstore = [&](int bsel) {
        LAS unsigned char* base = lds + bsel * AT_BUF;
#pragma unroll
        for (int i = 0; i < 3; ++i) *(LAS u32x4*)(base + klo + i * 128) = kreg[i];
#pragma unroll
        for (int i = 0; i < 2; ++i) { LAS unsigned char* vp = base + vlo + i * 64 * AT_VROW;
            *(LAS u32x2*)vp = (u32x2){vreg[i].x, vreg[i].y}; *(LAS u32x2*)(vp + 8) = (u32x2){vreg[i].z, vreg[i].w}; }
    };
    __syncthreads();
    gload(0); lstore(0);
    __syncthreads();
    const int nt = nk >> 6;
    for (int t = 0; t < nt; ++t) {
        if (t + 1 < nt) gload(t + 1);
        __builtin_amdgcn_sched_barrier(0);
        const LAS unsigned char* base = lds + (t & 1) * AT_BUF;
        f32x16 s0, s1;
#pragma unroll
        for (int j = 0; j < 16; ++j) { s0[j] = 0.f; s1[j] = 0.f; }
#pragma unroll
        for (int s = 0; s < 12; ++s) {
            const bf16x8 a0 = *(const LAS bf16x8*)(base + ql * AT_KROW + (16 * s + 8 * g) * 2);
            const bf16x8 a1 = *(const LAS bf16x8*)(base + (32 + ql) * AT_KROW + (16 * s + 8 * g) * 2);
            s0 = __builtin_amdgcn_mfma_f32_32x32x16_bf16(a0, qf[s], s0, 0, 0, 0);
            s1 = __builtin_amdgcn_mfma_f32_32x32x16_bf16(a1, qf[s], s1, 0, 0, 0);
            if ((s & 3) == 3) __builtin_amdgcn_sched_barrier(0);
        }
        float mx = s0[0];
#pragma unroll
        for (int j = 1; j < 16; ++j) mx = fmaxf(mx, s0[j]);
#pragma unroll
        for (int j = 0; j < 16; ++j) mx = fmaxf(mx, s1[j]);
        mx = fmaxf(mx, __shfl_xor(mx, 32));
        const float mnew = fmaxf(mrun, mx);
        const float alpha = __builtin_amdgcn_exp2f(mrun - mnew);
        mrun = mnew;
        float ps = 0.f;
#pragma unroll
        for (int j = 0; j < 16; ++j) { s0[j] = __builtin_amdgcn_exp2f(s0[j] - mnew); s1[j] = __builtin_amdgcn_exp2f(s1[j] - mnew); ps += s0[j] + s1[j]; }
        lsum = lsum * alpha + ps;
        if (__ballot(alpha != 1.0f) != 0ull) {
#pragma unroll
            for (int i = 0; i < 4; ++i) o[i] *= alpha;
        }
#pragma unroll
        for (int sub = 0; sub < 2; ++sub)
#pragma unroll
            for (int sp = 0; sp < 2; ++sp) {
                u32x4 pw;
                if (sub == 0) { pw.x = pack2(s0[8 * sp], s0[8 * sp + 1]); pw.y = pack2(s0[8 * sp + 2], s0[8 * sp + 3]); pw.z = pack2(s0[8 * sp + 4], s0[8 * sp + 5]); pw.w = pack2(s0[8 * sp + 6], s0[8 * sp + 7]); }
                else { pw.x = pack2(s1[8 * sp], s1[8 * sp + 1]); pw.y = pack2(s1[8 * sp + 2], s1[8 * sp + 3]); pw.z = pack2(s1[8 * sp + 4], s1[8 * sp + 5]); pw.w = pack2(s1[8 * sp + 6], s1[8 * sp + 7]); }
                const bf16x8 pf = __builtin_bit_cast(bf16x8, pw);
                const int kb = 32 * sub + 16 * sp + 4 * g;
#pragma unroll
                for (int blk = 0; blk < 4; ++blk) {
                    const LAS unsigned char* vp = base + AT_KSZ + (32 * blk + ql) * AT_VROW + kb * 2;
                    const s16x4 lo = *(const LAS s16x4*)vp, hi = *(const LAS s16x4*)(vp + 16);
                    const bf16x8 va = __builtin_shufflevector(lo, hi, 0, 1, 2, 3, 4, 5, 6, 7);
                    o[blk] = __builtin_amdgcn_mfma_f32_32x32x16_bf16(va, pf, o[blk], 0, 0, 0);
                }
                __builtin_amdgcn_sched_barrier(0);
            }
        if (t + 1 < nt) lstore((t + 1) & 1);
        __syncthreads();
    }
    lsum += __shfl_xor(lsum, 32);
    const float inv = 1.0f / lsum;
    u16* ACT = (u16*)(p->ws + OFF_ACT) + (size_t)(orow0 + wid * 32 + ql) * D + h * 128;
#pragma unroll
    for (int blk = 0; blk < 4; ++blk)
#pragma unroll
        for (int i4 = 0; i4 < 4; ++i4) {
            u32x2 w; w.x = pack2(o[blk][4 * i4] * inv, o[blk][4 * i4 + 1] * inv); w.y = pack2(o[blk][4 * i4 + 2] * inv, o[blk][4 * i4 + 3] * inv);
            *(u32x2*)(ACT + 32 * blk + 8 * i4 + 4 * g) = w;
        }
}
DI void mixer_phase(PP p, int l, LAS unsigned char* lds) {
    for (int rr = 0; rr < 1 + SCANREP; ++rr)
    for (int item = blockIdx.x; item < 256; item += gridDim.x) scan_item(p, l, item, lds);
    const int nunits = 256 + (l == 0 ? 32 : 0);
    for (int u = blockIdx.x; u < nunits; u += gridDim.x) {
        if (u < 256) {
            const int xcd = u & 7, idx = u >> 3; const int grp = xcd * 4 + (idx >> 3), qb = idx & 7; const int b = grp >> 2, h = grp & 3;
            attn_unit(p, b, h, CTX + qb * 256, KP, NCT + b * SEQ + qb * 256, lds);
        } else {
            const int cu = u - 256; const int b = cu >> 2, h = cu & 3;
            attn_unit(p, b, h, 0, CTX, b * CTX, lds);
        }
    }
}

DI void rwkv_out_phase(PP p, int l) {
    const int tid = tid_(); const int wid = tid >> 6, lane = tid & 63;
    const u16* RKV = (const u16*)(p->ws + OFF_RKV); const u16* Y = (const u16*)(p->ws + X_Y);
    const u16* AA = (const u16*)(p->ws + X_AA); const u16* G = (const u16*)(p->ws + X_G); u16* ACT = (u16*)(p->ws + OFF_ACT);
    const int row_lo = (l == 0) ? 0 : NCT;
    const size_t n_items = (size_t)(NTOK - row_lo) * 2;
    const int h0 = (int)((blockIdx.x * 8 + wid) & 1) * 4;
    const int c = (h0 + (lane >> 4)) * 64 + (lane & 15) * 4;
    const f32x4 lng = *(const f32x4*)(p->in[I_LNG] + l * 512 + c), lnb = *(const f32x4*)(p->in[I_LNB] + l * 512 + c);
    const f32x4 kaw = *(const f32x4*)(p->in[I_KA] + l * 512 + c), rkw = *(const f32x4*)(p->in[I_RK] + l * 512 + c);
#define UNP4(w_, o_) do { (o_)[0] = bflo((w_).x); (o_)[1] = bfhi((w_).x); (o_)[2] = bflo((w_).y); (o_)[3] = bfhi((w_).y); } while (0)
    const size_t istep = (size_t)gridDim.x * 8;
    for (size_t it = (size_t)blockIdx.x * 8 + wid; it < n_items; it += 2 * istep) {
        const bool has2 = it + istep < n_items;
        const int rowA = row_lo + (int)(it >> 1), rowB = has2 ? row_lo + (int)((it + istep) >> 1) : rowA;
        u32x2 wy0[2], wy1[2], wr[2], wk[2], wv[2], wf[2], wb[2], wg[2];
#pragma unroll
        for (int q = 0; q < 2; ++q) { const size_t o = (size_t)(q ? rowB : rowA) * 512 + c;
            wy0[q] = *(const u32x2*)(Y + o); wy1[q] = *(const u32x2*)(Y + (size_t)NTOK * 512 + o);
            wr[q] = *(const u32x2*)(RKV + o); wk[q] = *(const u32x2*)(RKV + (size_t)NTOK * 512 + o); wv[q] = *(const u32x2*)(RKV + (size_t)2 * NTOK * 512 + o);
            wf[q] = *(const u32x2*)(AA + o); wb[q] = *(const u32x2*)(AA + (size_t)NTOK * 512 + o); wg[q] = *(const u32x2*)(G + o); }
#pragma unroll
        for (int q = 0; q < 2; ++q) {
            if (q == 1 && !has2) break;
            const int row = q ? rowB : rowA;
            f32x4 y0, y1, r, k, v, af, ab, g;
            UNP4(wy0[q], y0); UNP4(wy1[q], y1); UNP4(wr[q], r); UNP4(wk[q], k); UNP4(wv[q], v); UNP4(wf[q], af); UNP4(wb[q], ab); UNP4(wg[q], g);
            const f32x4 y = y0 + y1;
            const f32x4 bnv = r * k * ((af + ab - 2.0f) * kaw + 2.0f) * rkw;
            float msum = (y[0] + y[1]) + (y[2] + y[3]), bsum = (bnv[0] + bnv[1]) + (bnv[2] + bnv[3]);
            msum = red16(msum); bsum = red16(bsum);
            const f32x4 d = y - msum * (1.0f / 64.0f);
            float vs = (d[0] * d[0] + d[1] * d[1]) + (d[2] * d[2] + d[3] * d[3]);
            vs = red16(vs);
            const f32x4 yn = d * rsqrtf(vs * (1.0f / 64.0f) + 64e-5f) * lng + lnb;
            const f32x4 out = (yn + v * bsum) * g;
            u32x2 w; w.x = pack2(out[0], out[1]); w.y = pack2(out[2], out[3]);
            *(u32x2*)(ACT + (size_t)row * D + 512 + c) = w;
        }
    }
#undef UNP4
}

#define XB_TMO      128
#define XB_XCNT(j)  (256  + 64 * (j))
#define XB_XSUB(j)  (1280 + 64 * (j))
#define XB_XGEN(j)  (2304 + 64 * (j))
#define XB_TOP      3328
#define XB_TOPGEN   3392
#define XCD_BAR_WORDS 3456
#define XB_SPIN_CAP (1u << 18)

__device__ __forceinline__ unsigned xb_ld(unsigned* p)              { return __hip_atomic_load(p, __ATOMIC_RELAXED, __HIP_MEMORY_SCOPE_AGENT); }
__device__ __forceinline__ unsigned xb_add(unsigned* p, unsigned v) { return __hip_atomic_fetch_add(p, v, __ATOMIC_RELAXED, __HIP_MEMORY_SCOPE_AGENT); }
__device__ __forceinline__ unsigned xb_xcc_id() { return (unsigned)__builtin_amdgcn_s_getreg((3 << 11) | 20) & 0xFu; }
#define XB_SPIN(cond, bar) do { unsigned _sp = 0; while (cond) { __builtin_amdgcn_s_sleep(1); \
    if ((++_sp & 255u) == 0u) { if (xb_ld(&(bar)[XB_TMO])) break; if (_sp > XB_SPIN_CAP) { atomicAdd(&(bar)[XB_TMO], 1u); break; } } } } while (0)

struct XcdBarrier {
    unsigned* bar; unsigned x;
    volatile LAS unsigned* st;
};

__device__ __forceinline__ XcdBarrier xcd_barrier_post(unsigned* bar, volatile LAS unsigned* st) {
    XcdBarrier b; b.bar = bar; b.x = xb_xcc_id(); b.st = st;
    if (threadIdx.x == 0) (void)xb_add(&bar[XB_XCNT(b.x)], 1u);
    return b;
}
__device__ __forceinline__ void xcd_barrier_complete(unsigned* bar, unsigned x, unsigned& nloc, unsigned& nx) {
    const unsigned G = gridDim.x * gridDim.y * gridDim.z;
    unsigned sum, cnt, mine, sp = 0u;
    for (;;) {
        sum = 0u; cnt = 0u; mine = 0u;
#pragma unroll
        for (unsigned j = 0; j < 16; ++j) { const unsigned c = xb_ld(&bar[XB_XCNT(j)]); sum += c; cnt += (c > 0u) ? 1u : 0u; mine = (j == x) ? c : mine; }
        if (sum == G) break;
        __builtin_amdgcn_s_sleep(1);
        if ((++sp & 255u) == 0u) { if (xb_ld(&bar[XB_TMO])) break; if (sp > XB_SPIN_CAP) { atomicAdd(&bar[XB_TMO], 1u); break; } }
    }
    nloc = mine > 0u ? mine : 1u; nx = cnt > 0u ? cnt : 1u;
}

__device__ __forceinline__ void xcd_barrier(const XcdBarrier& b) {
    asm volatile("s_waitcnt vmcnt(0)" ::: "memory");
    __syncthreads();
    if (threadIdx.x == 0) {
        unsigned* bar = b.bar;
        __builtin_amdgcn_s_waitcnt(0);
        unsigned nloc = b.st[0], nx = b.st[1];
        if (nloc == 0u) { xcd_barrier_complete(bar, b.x, nloc, nx); b.st[0] = nloc; b.st[1] = nx; }
        const unsigned old = xb_add(&bar[XB_XSUB(b.x)], 1u);
        const unsigned gen = old / nloc;
        if (old + 1u == (gen + 1u) * nloc) {
            __builtin_amdgcn_fence(__ATOMIC_RELEASE, "agent");
            asm volatile("s_waitcnt vmcnt(0)" ::: "memory");
            const unsigned og = xb_add(&bar[XB_TOP], 1u);
            const unsigned tg = og / nx;
            if (og + 1u == (tg + 1u) * nx) xb_add(&bar[XB_TOPGEN], 1u);
            else XB_SPIN(xb_ld(&bar[XB_TOPGEN]) == tg, bar);
            __builtin_amdgcn_fence(__ATOMIC_ACQUIRE, "agent");
            xb_add(&bar[XB_XGEN(b.x)], 1u);
            asm volatile("s_waitcnt vmcnt(0)" ::: "memory");
        } else {
            XB_SPIN(xb_ld(&bar[XB_XGEN(b.x)]) == gen, bar);
            __builtin_amdgcn_fence(__ATOMIC_ACQUIRE, "agent");
            asm volatile("s_waitcnt vmcnt(0)" ::: "memory");
        }
    }
    __syncthreads();
}


constexpr int NPH = 22;
DI void run_phase(PP p, int ph, LAS unsigned char* lds) {
    unsigned char* ws = p->ws;
    u16* ACT = (u16*)(ws + OFF_ACT);
    float* HC = (float*)(ws + OFF_HCTX);
    const float* MOD = (const float*)(ws + OFF_MOD);
    __syncthreads();
    if (ph == 0 && (PHMASK & 1)) {
        mod_phase(p, lds);
        __syncthreads();
        conv_small(p, lds, 0); conv_small(p, lds, 1);
        conv_big(p, lds, 0, 0);
        return;
    }
    if (ph == NPH - 1) { if (PHMASK & 2) norm_phase(p, 1, 2, NCT); return; }
    const int l = (ph - 1) / 10, k = (ph - 1) % 10;
    const unsigned char* sm = ws + OFF_SMALL + (size_t)l * SZ_SMALL;
    const int lat_only = (l == 1);
    const int row_lo = lat_only ? NCT : 0; const int Mrows = NTOK - row_lo;
    switch (k) {
    case 0: if (!(PHMASK & (4<<0))) break;
        norm_phase(p, l, 0, 0);
        break;
    case 1: if (!(PHMASK & (4<<1))) break; {
        pg8::EpiBf16<0> E; E.O = (u16*)(ws + X_F); E.ldc = FN; E.row_off = 0;
        run_gemm(lds, ACT, (const u16*)(ws + OFF_WIN), NTOK, FN, D, E, 0);
        {
            const int nunits = (NTOK / 256) * (FN / 256), G = (int)gridDim.x, nfull = nunits % G;
            const bool part = (nfull > 0 && nfull < G);
            if (!part || (int)blockIdx.x >= nfull) {
                const int nwk = part ? G - nfull : 0, wk = part ? (int)blockIdx.x - nfull : 0;
                if (l == 0) conv_big(p, lds, 0, 1, nwk, wk);
                conv_big(p, lds, l, 2, nwk, wk); conv_big(p, lds, l, 3, nwk, wk);
            }
        }
    } break;
    case 2: if (!(PHMASK & (4<<2))) break; prep_phase(p, l); break;
    case 3: if (!(PHMASK & (4<<3))) break; {
        if (SUBM & 1) { pg8::EpiLora E; E.DEC = (float*)(ws + X_DEC); E.AA = (u16*)(ws + X_AA); E.G = (u16*)(ws + X_G); E.w0 = p->in[I_W0] + l * 1024; E.a0 = p->in[I_A0] + l * 1024;
          E.pn_off = 0; run_gemm(lds, (const u16*)(ws + OFF_ALORA), (const u16*)(sm + SZ_UQ + SZ_UKV), NTOK, 2048, 384, E, 0, 640, 640);
          E.pn_off = 8; run_gemm(lds, (const u16*)(ws + OFF_ALORA) + 384, (const u16*)(sm + SZ_UQ + SZ_UKV) + (size_t)2048 * 640 + 384, NTOK, 512, 256, E, 64, 640, 640); }
        if (SUBM & 2) { pg8::EpiKV E; E.K = (u16*)(ws + X_K); E.VT = (u16*)(ws + X_VT); E.row_off = 0;
          run_gemm(lds, (const u16*)(ws + OFF_AKV), (const u16*)(sm + SZ_UQ), NTOK, 1024, 256, E, 208); }
        if (SUBM & 4) { pg8::EpiQ E; E.Q = (u16*)(ws + X_Q); E.rope = (const float*)(ws + OFF_ROPE); E.row_off = row_lo; E.qscale = 0.07216878364870322f * 1.4426950408889634f;
          run_gemm(lds, (const u16*)(ws + OFF_AQ) + (size_t)row_lo * 384, (const u16*)sm, Mrows, 768, 384, E, 240); }
        if (SUBM & 8) { pg8::EpiBf16<0> E; E.O = ACT + 1024; E.ldc = D; E.row_off = row_lo;
          run_gemm(lds, (const u16*)(ws + OFF_APOOL) + (size_t)row_lo * 512, (const u16*)(sm + SZ_UQ + SZ_UKV + SZ_LORA), Mrows, 512, 512, E, 200); }
    } break;
    case 4: if (!(PHMASK & (4<<4))) break; mixer_phase(p, l, lds); break;
    case 5: if (!(PHMASK & (4<<5))) break;
        rwkv_out_phase(p, l);
        if (l == 0) conv_big(p, lds, 1, 0);
        break;
    case 6: if (!(PHMASK & (4<<6))) break; {
        pg8::EpiRes E; E.res_c = (l == 0) ? p->in[I_CTX] : HC; E.res_l = (l == 0) ? p->in[I_X] : p->out; E.h_c = HC; E.h_l = p->out; E.gate = MOD + (size_t)l * 9 * 12288 + 2 * D; E.row_off = row_lo;
        run_gemm(lds, ACT + (size_t)row_lo * D, (const u16*)(ws + OFF_WOUT), Mrows, D, D, E, 0);
    } break;
    case 7: if (!(PHMASK & (4<<7))) break;
        norm_phase(p, l, 1, row_lo);
        if (l == 0) conv_big(p, lds, 1, 1);
        break;
    case 8: if (!(PHMASK & (4<<8))) break; {
        pg8::EpiBf16<3> E; E.O = (u16*)(ws + X_H1); E.ldc = FFP; E.row_off = row_lo;
        run_gemm(lds, ACT + (size_t)row_lo * D, (const u16*)(ws + OFF_W1), Mrows, FF, D, E, 0);
    } break;
    case 9: if (!(PHMASK & (4<<9))) break; {
        if (l == 0) {
            pg8::EpiResAtomic EA; EA.h_c = HC; EA.gate = MOD + 5 * D;
            int Ms = NCT, Ns = D, Ks = FF / 4; asm volatile("" : "+s"(Ms), "+s"(Ns), "+s"(Ks));
            const int kq = (int)(blockIdx.x & 3);
            pg8::Gemm g; g.A = (const u16*)(ws + X_H1) + (size_t)kq * (FF / 4); g.Bt = (const u16*)(ws + OFF_W2) + (size_t)kq * (FF / 4); g.M = Ms; g.N = Ns; g.K = Ks; g.lda = FFP; g.ldb = FFP;
            pg8::StaticOrder S; S.init(Ms, Ns, (int)(gridDim.x >> 2), (int)(blockIdx.x >> 2));
            pg8::gemm_phase<pg8::EpiResAtomic, pg8::StaticOrder>(lds, g, S, EA);
        }
        pg8::EpiRes E; E.res_c = HC; E.res_l = p->out; E.h_c = HC; E.h_l = p->out; E.gate = MOD + (size_t)l * 9 * 12288 + 5 * D; E.row_off = NCT;
        run_gemm(lds, (const u16*)(ws + X_H1) + (size_t)NCT * FFP, (const u16*)(ws + OFF_W2), NLT, D, FF, E, 0, FFP, FFP);
    } break;
    }
}

__global__ void __launch_bounds__(512, 2) mega(Params p_unused) {
    extern __shared__ __attribute__((aligned(16))) unsigned char shm[];
    LAS unsigned char* lds = (LAS unsigned char*)shm;
    cg::grid_group grid = cg::this_grid();
    PP pk = (PP)__builtin_amdgcn_kernarg_segment_ptr();
    const int ph_lo = pk->ph_lo, ph_hi = pk->ph_hi, use_sync = pk->use_sync;
    volatile LAS unsigned* xst = (volatile LAS unsigned*)(lds + 131072);
    if (threadIdx.x == 0) { xst[0] = 0u; xst[1] = 0u; }
    __syncthreads();
    const XcdBarrier xb = xcd_barrier_post((unsigned*)(pk->ws + OFF_BAR), xst);
    for (int ph = ph_lo; ph < ph_hi; ++ph) {
        const int nrep = 1 + (((REPMASK >> ph) & 1) ? REPN : 0);
        for (int rr = 0; rr < nrep; ++rr) {
            PP q = pk; asm volatile("" : "+s"(q));
            run_phase(q, ph, lds);
            __builtin_amdgcn_s_waitcnt(0);
        }
        if (use_sync && ph + 1 < ph_hi) { if (use_sync == 2) grid.sync(); else xcd_barrier(xb); for (int q9 = 0; q9 < SYNCREP; ++q9) xcd_barrier(xb); }
    }
}

extern "C" void kernel_launch(void* const* d_in, const int* in_sizes, int n_in, void* d_out, int out_size, void* d_ws, size_t ws_size, hipStream_t stream) {
    static int grid = 0;
    if (grid == 0) {
        if (n_in != 31 || out_size != NLT * D || ws_size < WS_END) { fprintf(stderr, "kernel_launch: unexpected shapes (n_in %d out %d ws %zu need %zu)\n", n_in, out_size, ws_size, (size_t)WS_END); grid = -1; return; }
        if (hipFuncSetAttribute((const void*)mega, hipFuncAttributeMaxDynamicSharedMemorySize, LDS_BYTES) != hipSuccess) { fprintf(stderr, "kernel_launch: hipFuncSetAttribute failed\n"); grid = -1; return; }
        int dev = 0, cus = 0, per_cu = 0;
        hipGetDevice(&dev); hipDeviceGetAttribute(&cus, hipDeviceAttributeMultiprocessorCount, dev);
        hipOccupancyMaxActiveBlocksPerMultiprocessor(&per_cu, (const void*)mega, 512, LDS_BYTES);
        (void)hipGetLastError();
        if (per_cu < 1) per_cu = 1;
        grid = cus;
    }
    if (grid < 0) return;
    hipMemsetAsync((char*)d_ws + OFF_SMALL, 0, OFF_MOD + SZ_MOD, stream);
    Params p{};
    for (int i = 0; i < 31; ++i) p.in[i] = (const float*)d_in[i];
    p.out = (float*)d_out; p.ws = (unsigned char*)d_ws;
#if ONE_LAUNCH
    p.ph_lo = 0; p.ph_hi = NPH; p.use_sync = 1; p.pad = 0;
    void* args[] = {&p};
    hipError_t e = hipLaunchCooperativeKernel((const void*)mega, dim3(grid), dim3(512), args, LDS_BYTES, stream);
    if (e != hipSuccess) fprintf(stderr, "cooperative launch failed: %s (grid %d)\n", hipGetErrorString(e), grid);
#else
    for (int ph = 0; ph < NPH; ++ph) {
        p.ph_lo = ph; p.ph_hi = ph + 1; p.use_sync = 0; p.pad = 0;
        hipLaunchKernelGGL(mega, dim3(grid), dim3(512), LDS_BYTES, stream, p);
    }
#endif
}
```

```cpp
#include <hip/hip_runtime.h>
#include <hip/hip_cooperative_groups.h>
#include <cstdio>
namespace cg = cooperative_groups;

#ifndef ONE_LAUNCH
#define ONE_LAUNCH 1
#endif

#ifndef SUBM
#define SUBM 15
#endif
#ifndef REPMASK
#define REPMASK 0
#endif
#ifndef REPN
#define REPN 1
#endif
#ifndef SCANREP
#define SCANREP 0
#endif
#ifndef SYNCREP
#define SYNCREP 0
#endif
#ifndef PHMASK
#define PHMASK 0xfff
#endif
#define DI __device__ __forceinline__
#define LAS __attribute__((address_space(3)))
typedef unsigned short u16;
typedef short bf16x8 __attribute__((ext_vector_type(8)));
typedef short s16x4 __attribute__((ext_vector_type(4)));
typedef float f32x2 __attribute__((ext_vector_type(2)));
typedef float f32x4 __attribute__((ext_vector_type(4)));
typedef float f32x16 __attribute__((ext_vector_type(16)));
typedef unsigned u32x2 __attribute__((ext_vector_type(2)));
typedef unsigned u32x4 __attribute__((ext_vector_type(4)));
typedef __bf16 bf16x2_t __attribute__((ext_vector_type(2)));

constexpr int D = 2048, NB = 8, SEQ = 2048, CTX = 256;
constexpr int NCT = NB * CTX, NLT = NB * SEQ, NTOK = NCT + NLT;
constexpr int FN = 4864;
constexpr int C_KV = 384, C_KR = 512, C_RW = 576, C_POOL = 2752, C_GB = 3264, C_GC = 3776, C_HX = 4288;
constexpr int KP = CTX + SEQ;
constexpr int FF = 8192, FFP = 8192 + 64;
constexpr int LDS_BYTES = 131072 + 16;

constexpr size_t al256(size_t x) { return (x + 255) & ~(size_t)255; }
constexpr size_t SZ_UQ = 768 * 384 * 2, SZ_UKV = 1024 * 256 * 2, SZ_LORA = 2560 * 640 * 2, SZ_POOLW = 512 * 512 * 2;
constexpr size_t SZ_SMALL = SZ_UQ + SZ_UKV + SZ_LORA + SZ_POOLW;
constexpr size_t OFF_SMALL = 0;
constexpr size_t OFF_BAR = 2 * SZ_SMALL;
constexpr size_t ZERO_BYTES = OFF_BAR + 16384;
constexpr size_t OFF_MOD = al256(ZERO_BYTES);
constexpr size_t SZ_MOD = (size_t)2 * 9 * 6 * 2048 * 4;
constexpr size_t OFF_ROPE = al256(OFF_MOD + SZ_MOD);
constexpr size_t OFF_WIN = al256(OFF_ROPE + 64 * 16 * 2 * 4);
constexpr size_t OFF_WOUT = al256(OFF_WIN + (size_t)FN * 2048 * 2);
constexpr size_t OFF_W1 = al256(OFF_WOUT + (size_t)2048 * 2048 * 2);
constexpr size_t OFF_W2 = al256(OFF_W1 + (size_t)FF * 2048 * 2);
constexpr size_t OFF_HCTX = al256(OFF_W2 + (size_t)FFP * 2048 * 2);
constexpr size_t OFF_ACT = al256(OFF_HCTX + (size_t)NCT * 2048 * 4);
constexpr size_t OFF_RKV = al256(OFF_ACT + (size_t)NTOK * 2048 * 2);
constexpr size_t OFF_ALORA = al256(OFF_RKV + (size_t)3 * NTOK * 512 * 4);
constexpr size_t OFF_APOOL = al256(OFF_ALORA + (size_t)NTOK * 640 * 2);
constexpr size_t OFF_AQ = al256(OFF_APOOL + (size_t)NTOK * 512 * 2);
constexpr size_t OFF_AKV = al256(OFF_AQ + (size_t)NTOK * 384 * 2);
constexpr size_t OFF_KPE = al256(OFF_AKV + (size_t)NTOK * 256 * 2);
constexpr size_t OFF_X = al256(OFF_KPE + (size_t)NTOK * 64 * 2);
constexpr size_t X_F = OFF_X, X_H1 = OFF_X;
constexpr size_t X_DEC = OFF_X;
constexpr size_t X_AA = al256(X_DEC + (size_t)2 * NTOK * 512 * 4);
constexpr size_t X_G = al256(X_AA + (size_t)2 * NTOK * 512 * 2);
constexpr size_t X_Q = al256(X_G + (size_t)NTOK * 512 * 2);
constexpr size_t X_K = al256(X_Q + (size_t)NTOK * 768 * 2);
constexpr size_t X_VT = al256(X_K + (size_t)NTOK * 768 * 2);
constexpr size_t X_Y = al256(X_VT + (size_t)NTOK * 512 * 2);
constexpr size_t X_END = al256(X_Y + (size_t)2 * NTOK * 512 * 4);
constexpr size_t WS_END = OFF_X + (size_t)NTOK * FFP * 2;
static_assert(X_END <= WS_END, "region X overflow");
static_assert(X_F + (size_t)NTOK * FN * 2 <= WS_END, "F overflow");

struct Params {
    const float* in[31];
    float* out;
    unsigned char* ws;
    int ph_lo, ph_hi, use_sync, pad;
};
typedef const __attribute__((address_space(4))) Params* PP;
enum { I_X = 0, I_C, I_CTX, I_CCTX, I_ADAW, I_ADAB, I_N1G, I_N2G, I_WIN, I_QNG, I_WUQ, I_KVNG, I_WUKV, I_MU, I_W0, I_W2, I_A0, I_A2, I_G2,
       I_KK, I_KA, I_RK, I_LNG, I_LNB, I_POOLW, I_POOLS, I_CONVW, I_WOUT, I_MW1, I_MW2, I_FNG };

DI unsigned pack2(float lo, float hi) { f32x2 v = {lo, hi}; return __builtin_bit_cast(unsigned, __builtin_convertvector(v, bf16x2_t)); }
DI float bf2f(u16 b) { return __uint_as_float(((unsigned)b) << 16); }
DI float bflo(unsigned w) { return __uint_as_float(w << 16); }
DI float bfhi(unsigned w) { return __uint_as_float(w & 0xffff0000u); }
DI float wave_sum(float x) {
#pragma unroll
    for (int o = 32; o >= 1; o >>= 1) x += __shfl_xor(x, o);
    return x;
}
DI float dpp_f(float x, const int ctrl_sel) {
    int r;
    if (ctrl_sel == 0) r = __builtin_amdgcn_update_dpp(0, __builtin_bit_cast(int, x), 0xB1, 0xF, 0xF, true);
    else if (ctrl_sel == 1) r = __builtin_amdgcn_update_dpp(0, __builtin_bit_cast(int, x), 0x4E, 0xF, 0xF, true);
    else if (ctrl_sel == 2) r = __builtin_amdgcn_update_dpp(0, __builtin_bit_cast(int, x), 0x141, 0xF, 0xF, true);
    else r = __builtin_amdgcn_update_dpp(0, __builtin_bit_cast(int, x), 0x140, 0xF, 0xF, true);
    return __builtin_bit_cast(float, r);
}
DI float dpp_xor1(float x) { return __builtin_bit_cast(float, __builtin_amdgcn_update_dpp(0, __builtin_bit_cast(int, x), 0xB1, 0xF, 0xF, true)); }
DI float dpp_xor2(float x) { return __builtin_bit_cast(float, __builtin_amdgcn_update_dpp(0, __builtin_bit_cast(int, x), 0x4E, 0xF, 0xF, true)); }
DI float dpp_shl4(float x) { return __builtin_bit_cast(float, __builtin_amdgcn_update_dpp(0, __builtin_bit_cast(int, x), 0x104, 0xF, 0xF, true)); }
DI float dpp_shr4(float x) { return __builtin_bit_cast(float, __builtin_amdgcn_update_dpp(0, __builtin_bit_cast(int, x), 0x114, 0xF, 0xF, true)); }
DI float red8(float x) { x += dpp_f(x, 0); x += dpp_f(x, 1); x += dpp_f(x, 2); return x; }
DI float red16(float x) { x += dpp_f(x, 0); x += dpp_f(x, 1); x += dpp_f(x, 2); x += dpp_f(x, 3); return x; }
template <int N> DI void wsum_n(float (&x)[N]) {
#pragma unroll
    for (int i = 0; i < N; ++i) x[i] += dpp_f(x[i], 0);
#pragma unroll
    for (int i = 0; i < N; ++i) x[i] += dpp_f(x[i], 1);
#pragma unroll
    for (int i = 0; i < N; ++i) x[i] += dpp_f(x[i], 2);
#pragma unroll
    for (int i = 0; i < N; ++i) x[i] += dpp_f(x[i], 3);
#pragma unroll
    for (int i = 0; i < N; ++i) x[i] += __shfl_xor(x[i], 16);
#pragma unroll
    for (int i = 0; i < N; ++i) x[i] += __shfl_xor(x[i], 32);
}
DI int tid_() { int t = threadIdx.x; asm volatile("" : "+v"(t)); return t; }
DI int modrow(int row) { return row < NCT ? 8 : ((row - NCT) >> 11); }
DI float sigmoidf_(float x) { return 1.0f / (1.0f + __expf(-x)); }

namespace pg8 {
typedef u16 bf16_t;
constexpr int BM = 256, BK = 64, HALF = 128, HTB = HALF * BK * 2, STAGE_BYTES = 8 * HTB, NXCD = 8, WGM = 8;
DI int lds_byte(int r, int c) { const int st = (r >> 4) * 2 + (c >> 5), rr = r & 15, cc = c & 31, ob = rr * 64 + cc * 2; return st * 1024 + (ob ^ (((ob >> 9) & 1) << 5)); }
DI void stage_rc(int b, int& R, int& C) { const int st = b / 1024, sb = b % 1024, swz = sb ^ (((sb >> 9) & 1) << 5); R = (st >> 1) * 16 + swz / 64; C = (st & 1) * 32 + (swz % 64) / 2; }
DI int perm32(int rho) { const int n = rho >> 4, i = rho & 15; return 8 * (i >> 2) + 4 * n + (i & 3); }
struct Unit { int pm, pn; };
struct Gemm { const bf16_t* A; const bf16_t* Bt; int M, N, K, lda, ldb; };
struct StaticOrder {
    int nM, nN, nwg, G, c;
    DI void init(int M, int N, int G_, int c_) { nM = M / BM; nN = N / BM; nwg = nM * nN; G = G_; c = c_; }
    DI bool next(int i, Unit& u) const {
        const long L = (long)i * G + c; if (L >= nwg) return false;
        int wgid = (int)L; { const int q = nwg / NXCD, r = nwg % NXCD, xcd = wgid % NXCD, off = wgid / NXCD; wgid = (xcd < r ? xcd * (q + 1) : r * (q + 1) + (xcd - r) * q) + off; }
        const int nig = WGM * nN, gid = wgid / nig, fm = gid * WGM, gsz = (nM - fm) < WGM ? (nM - fm) : WGM;
        u.pm = fm + ((wgid % nig) % gsz); u.pn = (wgid % nig) / gsz; return true;
    }
    DI void a_ready(const Unit&) const {}
    DI void done(const Unit&) const {}
};
DI unsigned cvt_pk_bf16(float lo, float hi) { return pack2(lo, hi); }

template <int ACT> struct EpiBf16 {
    static constexpr bool PERM = true, AFTER_DRAIN = false;
    bf16_t* O; int ldc; int row_off;
    DI void operator()(const f32x4 (&acc)[2][2][4][2], const Unit& u, int wr, int wc, int fr, int fq) const {
        const int row0 = u.pm * BM + row_off + wr * 64 + fr; const int col0 = u.pn * BM + wc * 32 + 8 * fq;
#pragma unroll
        for (int ai = 0; ai < 2; ++ai)
#pragma unroll
            for (int m = 0; m < 4; ++m) { bf16_t* rowp = O + (size_t)(row0 + ai * HALF + m * 16) * ldc + col0;
#pragma unroll
                for (int bj = 0; bj < 2; ++bj) { f32x4 v0 = acc[ai][bj][m][0], v1 = acc[ai][bj][m][1];
                    if (ACT == 3) {
#pragma unroll
                        for (int j = 0; j < 4; ++j) { float a = fmaxf(v0[j], 0.f), b = fmaxf(v1[j], 0.f); v0[j] = a * a; v1[j] = b * b; } }
                    u32x4 w; w.x = cvt_pk_bf16(v0[0], v0[1]); w.y = cvt_pk_bf16(v0[2], v0[3]); w.z = cvt_pk_bf16(v1[0], v1[1]); w.w = cvt_pk_bf16(v1[2], v1[3]);
                    *(u32x4*)(rowp + bj * HALF) = w; } }
    }
};
struct EpiRes {
    static constexpr bool PERM = false, AFTER_DRAIN = false;
    const float* res_c; const float* res_l; float* h_c; float* h_l; const float* gate; int row_off;
    DI void operator()(const f32x4 (&acc)[2][2][4][2], const Unit& u, int wr, int wc, int fr, int fq) const {
        const int rbase = u.pm * BM + row_off; const bool isc = rbase < NCT; const int mr = isc ? 8 : ((rbase - NCT) >> 11);
        const float* rp = isc ? res_c + (size_t)rbase * D : res_l + (size_t)(rbase - NCT) * D;
        float* hp = isc ? h_c + (size_t)rbase * D : h_l + (size_t)(rbase - NCT) * D;
        const float* g = gate + (size_t)mr * (6 * D);
        const int col0 = u.pn * BM + wc * 32 + 4 * fq;
        f32x4 gv[2][2];
#pragma unroll
        for (int bj = 0; bj < 2; ++bj)
#pragma unroll
            for (int n = 0; n < 2; ++n) gv[bj][n] = *(const f32x4*)(g + col0 + bj * HALF + n * 16);
#pragma unroll
        for (int ai = 0; ai < 2; ++ai) {
            f32x4 r[4][2][2];
#pragma unroll
            for (int m = 0; m < 4; ++m) { const size_t ro = (size_t)(wr * 64 + fr + ai * HALF + m * 16) * D + col0;
#pragma unroll
                for (int bj = 0; bj < 2; ++bj)
#pragma unroll
                    for (int n = 0; n < 2; ++n) r[m][bj][n] = *(const f32x4*)(rp + ro + bj * HALF + n * 16); }
            __builtin_amdgcn_sched_barrier(0);
#pragma unroll
            for (int m = 0; m < 4; ++m) { const size_t ro = (size_t)(wr * 64 + fr + ai * HALF + m * 16) * D + col0;
#pragma unroll
                for (int bj = 0; bj < 2; ++bj)
#pragma unroll
                    for (int n = 0; n < 2; ++n) *(f32x4*)(hp + ro + bj * HALF + n * 16) = r[m][bj][n] + gv[bj][n] * acc[ai][bj][m][n]; }
            __builtin_amdgcn_sched_barrier(0);
        }
    }
};
struct EpiResAtomic {
    static constexpr bool PERM = false, AFTER_DRAIN = false;
    float* h_c; const float* gate;
    DI void operator()(const f32x4 (&acc)[2][2][4][2], const Unit& u, int wr, int wc, int fr, int fq) const {
        float* hp = h_c + (size_t)(u.pm * BM) * D;
        const float* g = gate + (size_t)8 * (6 * D);
        const int col0 = u.pn * BM + wc * 32 + 4 * fq;
        f32x4 gv[2][2];
#pragma unroll
        for (int bj = 0; bj < 2; ++bj)
#pragma unroll
            for (int n = 0; n < 2; ++n) gv[bj][n] = *(const f32x4*)(g + col0 + bj * HALF + n * 16);
#pragma unroll
        for (int ai = 0; ai < 2; ++ai)
#pragma unroll
            for (int m = 0; m < 4; ++m) { float* rp = hp + (size_t)(wr * 64 + fr + ai * HALF + m * 16) * D + col0;
#pragma unroll
                for (int bj = 0; bj < 2; ++bj)
#pragma unroll
                    for (int n = 0; n < 2; ++n) { const f32x4 v = gv[bj][n] * acc[ai][bj][m][n];
#pragma unroll
                        for (int j = 0; j < 4; ++j) __hip_atomic_fetch_add(rp + bj * HALF + n * 16 + j, v[j], __ATOMIC_RELAXED, __HIP_MEMORY_SCOPE_AGENT); } }
    }
};
struct EpiQ {
    static constexpr bool PERM = false, AFTER_DRAIN = false;
    bf16_t* Q; const float* rope; int row_off; float qscale;
    DI void operator()(const f32x4 (&acc)[2][2][4][2], const Unit& u, int wr, int wc, int fr, int fq) const {
        const int rbase = u.pm * BM + row_off; const bool isc = rbase < NCT;
#pragma unroll
        for (int ai = 0; ai < 2; ++ai)
#pragma unroll
            for (int m = 0; m < 4; ++m) {
                const int row = rbase + wr * 64 + fr + ai * HALF + m * 16;
                int b, pos, t;
                if (isc) { b = row >> 8; t = row & 255; pos = t; } else { b = (row - NCT) >> 11; t = (row - NCT) & 2047; pos = CTX + t; }
#pragma unroll
                for (int bj = 0; bj < 2; ++bj) {
                    const int c0 = u.pn * BM + bj * HALF + wc * 32;
                    const int hh = c0 / 192, within0 = c0 - hh * 192;
                    f32x4 v0 = acc[ai][bj][m][0] * qscale, v1 = acc[ai][bj][m][1] * qscale;
                    if (within0 >= 128 && !isc) {
                        const int ax = (within0 - 128) >> 5; const int pp = ax ? (t & 63) : (t >> 6);
                        const float* rt = rope + (size_t)(pp * 16 + 4 * fq) * 2;
#pragma unroll
                        for (int j = 0; j < 4; ++j) { const float cs = rt[2 * j], sn = rt[2 * j + 1]; const float x1 = v0[j], x2 = v1[j]; v0[j] = x1 * cs - x2 * sn; v1[j] = x2 * cs + x1 * sn; }
                    }
                    bf16_t* qp = Q + ((size_t)(b * 4 + hh) * KP + pos) * 192 + within0 + 4 * fq;
                    u32x2 w0, w1; w0.x = pack2(v0[0], v0[1]); w0.y = pack2(v0[2], v0[3]); w1.x = pack2(v1[0], v1[1]); w1.y = pack2(v1[2], v1[3]);
                    *(u32x2*)(qp) = w0; *(u32x2*)(qp + 16) = w1;
                }
                __builtin_amdgcn_sched_barrier(0);
            }
    }
};
struct EpiKV {
    static constexpr bool PERM = true, AFTER_DRAIN = false;
    bf16_t* K; bf16_t* VT; int row_off;
    DI void operator()(const f32x4 (&acc)[2][2][4][2], const Unit& u, int wr, int wc, int fr, int fq) const {
        const int rbase = u.pm * BM + row_off; const bool isc = rbase < NCT; const int hh = u.pn;
#pragma unroll
        for (int ai = 0; ai < 2; ++ai)
#pragma unroll
            for (int m = 0; m < 4; ++m) {
                const int row = rbase + wr * 64 + fr + ai * HALF + m * 16;
                int b, pos;
                if (isc) { b = row >> 8; pos = row & 255; } else { b = (row - NCT) >> 11; pos = CTX + ((row - NCT) & 2047); }
                const int d0 = wc * 32 + 8 * fq;
                { const f32x4 v0 = acc[ai][0][m][0], v1 = acc[ai][0][m][1];
                  u32x4 w; w.x = pack2(v0[0], v0[1]); w.y = pack2(v0[2], v0[3]); w.z = pack2(v1[0], v1[1]); w.w = pack2(v1[2], v1[3]);
                  *(u32x4*)(K + ((size_t)(b * 4 + hh) * KP + pos) * 128 + d0) = w; }
                { const f32x4 v0 = acc[ai][1][m][0], v1 = acc[ai][1][m][1];
                  bf16_t* vp = VT + (((size_t)(b * 4 + hh) * (KP / 64) + (pos >> 6)) * 128 + d0) * 64 + (pos & 63);
#pragma unroll
                  for (int j = 0; j < 4; ++j) { vp[j * 64] = (bf16_t)(pack2(v0[j], 0.f) & 0xffffu); vp[(4 + j) * 64] = (bf16_t)(pack2(v1[j], 0.f) & 0xffffu); } }
                __builtin_amdgcn_sched_barrier(0);
            }
    }
};
struct EpiLora {
    static constexpr bool PERM = true, AFTER_DRAIN = false;
    float* DEC; bf16_t* AA; bf16_t* G; const float* w0; const float* a0; int pn_off;
    DI void operator()(const f32x4 (&acc)[2][2][4][2], const Unit& u, int wr, int wc, int fr, int fq) const {
        const int sect = (u.pn + pn_off) >> 1; const int row0 = u.pm * BM + wr * 64 + fr;
#pragma unroll
        for (int bj = 0; bj < 2; ++bj) {
            const int ch = (u.pn & 1) * 256 + bj * HALF + wc * 32 + 8 * fq;
            float bias[8];
            if (sect < 2) {
#pragma unroll
                for (int j = 0; j < 8; ++j) bias[j] = w0[sect * 512 + ch + j];
            } else if (sect < 4) {
#pragma unroll
                for (int j = 0; j < 8; ++j) bias[j] = a0[(sect - 2) * 512 + ch + j];
            } else {
#pragma unroll
                for (int j = 0; j < 8; ++j) bias[j] = 0.f;
            }
#pragma unroll
            for (int ai = 0; ai < 2; ++ai)
#pragma unroll
                for (int m = 0; m < 4; ++m) {
                    const int row = row0 + ai * HALF + m * 16;
                    float v[8];
#pragma unroll
                    for (int j = 0; j < 4; ++j) { v[j] = acc[ai][bj][m][0][j] + bias[j]; v[4 + j] = acc[ai][bj][m][1][j] + bias[4 + j]; }
                    if (sect < 2) {
#pragma unroll
                        for (int j = 0; j < 8; ++j) { const float w = -__logf(1.0f + __expf(-v[j])) - 0.5f; v[j] = __expf(-__expf(w)); }
                        float* dp = DEC + ((size_t)sect * NTOK + row) * 512 + ch;
                        *(f32x4*)dp = (f32x4){v[0], v[1], v[2], v[3]}; *(f32x4*)(dp + 4) = (f32x4){v[4], v[5], v[6], v[7]};
                    } else {
                        if (sect < 4) {
#pragma unroll
                            for (int j = 0; j < 8; ++j) v[j] = sigmoidf_(v[j]);
                        }
                        bf16_t* op = (sect < 4) ? AA + ((size_t)(sect - 2) * NTOK + row) * 512 + ch : G + (size_t)row * 512 + ch;
                        u32x4 w; w.x = pack2(v[0], v[1]); w.y = pack2(v[2], v[3]); w.z = pack2(v[4], v[5]); w.w = pack2(v[6], v[7]);
                        *(u32x4*)op = w;
                    }
                    __builtin_amdgcn_sched_barrier(0);
                }
        }
    }
};

template <class Epi, class Sched>
DI void gemm_phase(LAS unsigned char* lds, const Gemm g, const Sched& S, const Epi& E) {
    const int tid = tid_(), wid = __builtin_amdgcn_readfirstlane(tid >> 6), lane = tid & 63, wr = wid >> 2, wc = wid & 3, fr = lane & 15, fq = lane >> 4;
    const int K = g.K, nt = K / BK;
    unsigned voffA[2], voffB[2];
#pragma unroll
    for (int i = 0; i < 2; ++i) { int R, C; stage_rc(tid * 16 + i * 8192, R, C); const int Rb = Epi::PERM ? ((R & ~31) + perm32(R & 31)) : R;
        voffA[i] = (unsigned)(R * g.lda + C) * 2u; voffB[i] = (unsigned)(Rb * g.ldb + C) * 2u; }
    const size_t kstep = (size_t)(BK * 2);
    const size_t hstepA = (size_t)HALF * g.lda * 2, hstepB = (size_t)HALF * g.ldb * 2;
    const size_t tstepA = 2 * hstepA, tstepB = 2 * hstepB;
    const unsigned ldsw = (unsigned)wid * 1024u;
    const int aoff = lds_byte(wr * 64 + fr, fq * 8), boff = lds_byte(wc * 32 + fr, fq * 8);
#define PG8_SA(b, h) (((b) * 2 + (h)) * HTB)
#define PG8_SB(b, h) ((4 + (b) * 2 + (h)) * HTB)
#define PG8_STAGE(bufoff, gbase, voff) do { _Pragma("unroll") for (int _i = 0; _i < 2; ++_i) \
        __builtin_amdgcn_global_load_lds((const unsigned*)((const char*)(gbase) + (voff)[_i]), (LAS unsigned*)(lds + (bufoff) + ldsw + _i * 8192), 16, 0, 0); } while (0)
#define PG8_LDA(dst, b, h) do { _Pragma("unroll") for (int m = 0; m < 4; ++m) _Pragma("unroll") for (int k = 0; k < 2; ++k) dst[m][k] = *(const LAS bf16x8*)(lds + PG8_SA(b, h) + aoff + m * 2048 + k * 1024); } while (0)
#define PG8_LDB(dst, b, h) do { _Pragma("unroll") for (int n = 0; n < 2; ++n) _Pragma("unroll") for (int k = 0; k < 2; ++k) dst[n][k] = *(const LAS bf16x8*)(lds + PG8_SB(b, h) + boff + n * 2048 + k * 1024); } while (0)
#define PG8_MMA(ai, bj, At, Bt) do { __builtin_amdgcn_s_setprio(1); _Pragma("unroll") for (int m = 0; m < 4; ++m) _Pragma("unroll") for (int n = 0; n < 2; ++n) _Pragma("unroll") for (int k = 0; k < 2; ++k) \
        acc[ai][bj][m][n] = __builtin_amdgcn_mfma_f32_16x16x32_bf16(Bt[n][k], At[m][k], acc[ai][bj][m][n], 0, 0, 0); __builtin_amdgcn_s_setprio(0); } while (0)
#define PG8_WAIT_V(n) asm volatile("s_waitcnt vmcnt(" #n ")" ::: "memory")
#define PG8_WAIT_L(n) asm volatile("s_waitcnt lgkmcnt(" #n ")" ::: "memory")
#define PG8_BAR __builtin_amdgcn_s_barrier()
#define PG8_SCHED __builtin_amdgcn_sched_barrier(0)
    Unit cur, nxt; int ui = 0;
    if (!S.next(0, cur)) return;
    f32x4 acc[2][2][4][2];
#pragma unroll
    for (int a = 0; a < 2; ++a)
#pragma unroll
        for (int b = 0; b < 2; ++b)
#pragma unroll
            for (int m = 0; m < 4; ++m)
#pragma unroll
                for (int n = 0; n < 2; ++n) acc[a][b][m][n] = (f32x4){0.f, 0.f, 0.f, 0.f};
    bf16x8 At[4][2], B0[2][2], B1[2][2];
    const char* cA = (const char*)g.A + (size_t)cur.pm * tstepA; const char* cB = (const char*)g.Bt + (size_t)cur.pn * tstepB;
    S.a_ready(cur);
    PG8_STAGE(PG8_SB(0, 0), cB, voffB); PG8_STAGE(PG8_SA(0, 0), cA, voffA); PG8_STAGE(PG8_SB(0, 1), cB + hstepB, voffB); PG8_STAGE(PG8_SA(0, 1), cA + hstepA, voffA);
    if (wr == 1) PG8_BAR;
    PG8_WAIT_V(4); PG8_BAR;
    PG8_STAGE(PG8_SB(1, 0), cB + kstep, voffB); PG8_STAGE(PG8_SA(1, 0), cA + kstep, voffA); PG8_STAGE(PG8_SB(1, 1), cB + hstepB + kstep, voffB);
    PG8_WAIT_V(6); PG8_BAR;
    for (;;) {
        const bool has_next = S.next(ui + 1, nxt);
        const char* nA = has_next ? (const char*)g.A + (size_t)nxt.pm * tstepA : cA; const char* nB = has_next ? (const char*)g.Bt + (size_t)nxt.pn * tstepB : cB;
#pragma nounroll
        for (int t = 0; t < nt; t += 2) {
            const bool last = (t == nt - 2);
            const char* a1 = cA + (size_t)(t + 1) * kstep;
            const char* a2 = last ? nA : cA + (size_t)(t + 2) * kstep; const char* b2 = last ? nB : cB + (size_t)(t + 2) * kstep;
            const char* a3 = a2 + kstep; const char* b3 = b2 + kstep;
            if (last && has_next) S.a_ready(nxt);
            PG8_LDB(B0, 0, 0); PG8_SCHED; PG8_LDA(At, 0, 0); PG8_STAGE(PG8_SA(1, 1), a1 + hstepA, voffA);
            PG8_WAIT_L(8); PG8_BAR; PG8_WAIT_L(0); PG8_MMA(0, 0, At, B0); PG8_BAR; PG8_SCHED;
            PG8_LDB(B1, 0, 1); PG8_STAGE(PG8_SB(0, 0), b2, voffB);
            PG8_BAR; PG8_WAIT_L(0); PG8_MMA(0, 1, At, B1); PG8_BAR;
            PG8_LDA(At, 0, 1); PG8_STAGE(PG8_SA(0, 0), a2, voffA);
            PG8_BAR; PG8_WAIT_L(0); PG8_MMA(1, 0, At, B0); PG8_BAR; PG8_SCHED;
            PG8_STAGE(PG8_SB(0, 1), b2 + hstepB, voffB);
            PG8_WAIT_V(6); PG8_BAR; PG8_MMA(1, 1, At, B1); PG8_BAR;
            PG8_LDB(B0, 1, 0); PG8_SCHED; PG8_LDA(At, 1, 0); PG8_STAGE(PG8_SA(0, 1), a2 + hstepA, voffA);
            PG8_WAIT_L(8); PG8_BAR; PG8_WAIT_L(0); PG8_MMA(0, 0, At, B0); PG8_BAR; PG8_SCHED;
            PG8_LDB(B1, 1, 1); PG8_STAGE(PG8_SB(1, 0), b3, voffB);
            PG8_BAR; PG8_WAIT_L(0); PG8_MMA(0, 1, At, B1); PG8_BAR;
            PG8_LDA(At, 1, 1); PG8_STAGE(PG8_SA(1, 0), a3, voffA);
            PG8_BAR; PG8_WAIT_L(0); PG8_MMA(1, 0, At, B0); PG8_BAR; PG8_SCHED;
            PG8_STAGE(PG8_SB(1, 1), b3 + hstepB, voffB);
            PG8_WAIT_V(6); PG8_BAR; PG8_MMA(1, 1, At, B1); PG8_BAR;
        }
        { int fr_e = fr, fq_e = fq; asm volatile("" : "+v"(fr_e), "+v"(fq_e)); E(acc, cur, wr, wc, fr_e, fq_e); } S.done(cur);
        __builtin_amdgcn_s_waitcnt(0x0F70);
        if (!has_next) break;
#pragma unroll
        for (int a = 0; a < 2; ++a)
#pragma unroll
            for (int b = 0; b < 2; ++b)
#pragma unroll
                for (int m = 0; m < 4; ++m)
#pragma unroll
                    for (int n = 0; n < 2; ++n) acc[a][b][m][n] = (f32x4){0.f, 0.f, 0.f, 0.f};
        cur = nxt; cA = nA; cB = nB; ++ui;
    }
    PG8_WAIT_V(0);
    if (wr == 0) PG8_BAR;
    PG8_BAR;
#undef PG8_SA
#undef PG8_SB
#undef PG8_STAGE
#undef PG8_LDA
#undef PG8_LDB
#undef PG8_MMA
#undef PG8_WAIT_V
#undef PG8_WAIT_L
#undef PG8_BAR
#undef PG8_SCHED
}
}

template <class Epi>
DI void run_gemm(LAS unsigned char* lds, const u16* A, const u16* Bt, int M, int N, int K, const Epi& E, int rot, int lda = 0, int ldb = 0) {
    asm volatile("" : "+s"(K), "+s"(M), "+s"(N));
    pg8::Gemm g; g.A = A; g.Bt = Bt; g.M = M; g.N = N; g.K = K; g.lda = lda ? lda : K; g.ldb = ldb ? ldb : K;
    pg8::StaticOrder S; S.init(M, N, (int)gridDim.x, (int)((blockIdx.x + (unsigned)rot) % gridDim.x));
    pg8::gemm_phase<Epi, pg8::StaticOrder>(lds, g, S, E);
}

DI void conv_T(LAS unsigned char* lds, const float* src, int ld_src, int K, int N, u16* dst, int ld_dst, const float* colscale, int rot, int nwk = 0, int wk = 0) {
    LAS float* T = (LAS float*)lds;
    const int tid = tid_();
    const int nkt = (K + 63) >> 6, nng = (N + 255) >> 8, nitem = nkt * nng;
    const int t_step = nwk ? nwk : (int)gridDim.x; const int t_first = nwk ? wk : (int)((blockIdx.x + (unsigned)rot) % gridDim.x);
    for (int t = t_first; t < nitem; t += t_step) {
        const int kt = t / nng, ng = t - kt * nng; const int k0 = kt * 64, n0 = ng * 256;
        { const int kk = tid >> 4, n4 = (tid & 15) * 4;
          f32x4 v[4][2];
#pragma unroll
          for (int j = 0; j < 4; ++j)
#pragma unroll
              for (int ps = 0; ps < 2; ++ps) { const int k = k0 + kk + 32 * ps; v[j][ps] = (f32x4){0.f, 0.f, 0.f, 0.f};
                  if (k < K && n0 + 64 * j < N) v[j][ps] = *(const f32x4*)(src + (size_t)k * ld_src + n0 + 64 * j + n4); }
#pragma unroll
          for (int j = 0; j < 4; ++j)
#pragma unroll
              for (int ps = 0; ps < 2; ++ps) { LAS float* tp = T + j * (64 * 65) + (kk + 32 * ps) * 65 + n4; tp[0] = v[j][ps][0]; tp[1] = v[j][ps][1]; tp[2] = v[j][ps][2]; tp[3] = v[j][ps][3]; } }
        __syncthreads();
        { const int n = tid >> 3, k8 = (tid & 7) * 8;
          if (k0 + k8 < K) {
#pragma unroll
              for (int j = 0; j < 4; ++j) {
                  if (n0 + 64 * j < N) { const int nn = n0 + 64 * j + n; const float sc = colscale ? colscale[nn] : 1.0f; float v[8];
#pragma unroll
                      for (int i = 0; i < 8; ++i) v[i] = T[j * (64 * 65) + (k8 + i) * 65 + n] * sc;
                      u32x4 w; w.x = pack2(v[0], v[1]); w.y = pack2(v[2], v[3]); w.z = pack2(v[4], v[5]); w.w = pack2(v[6], v[7]);
                      *(u32x4*)(dst + (size_t)nn * ld_dst + k0 + k8) = w; } } } }
        __syncthreads();
    }
}
DI void conv_big(PP p, LAS unsigned char* lds, int l, int which, int nwk = 0, int wk = 0) {
    unsigned char* ws = p->ws;
    if (which == 0) conv_T(lds, p->in[I_WIN] + (size_t)l * 2048 * 4800, 4800, 2048, 4800, (u16*)(ws + OFF_WIN), 2048, nullptr, 0);
    else if (which == 1) conv_T(lds, p->in[I_WOUT] + (size_t)l * 2048 * 2048, 2048, 2048, 2048, (u16*)(ws + OFF_WOUT), 2048, nullptr, 96, nwk, wk);
    else if (which == 2) conv_T(lds, p->in[I_MW1] + (size_t)l * 2048 * FF, FF, 2048, FF, (u16*)(ws + OFF_W1), 2048, nullptr, 0, nwk, wk);
    else conv_T(lds, p->in[I_MW2] + (size_t)l * FF * 2048, 2048, FF, 2048, (u16*)(ws + OFF_W2), FFP, nullptr, 0, nwk, wk);
}
DI void conv_small(PP p, LAS unsigned char* lds, int l) {
    unsigned char* base = p->ws + OFF_SMALL + (size_t)l * SZ_SMALL;
    u16* uq = (u16*)base; u16* ukv = (u16*)(base + SZ_UQ); u16* lora = (u16*)(base + SZ_UQ + SZ_UKV); u16* pw = (u16*)(base + SZ_UQ + SZ_UKV + SZ_LORA);
    conv_T(lds, p->in[I_WUQ] + (size_t)l * 384 * 768, 768, 384, 768, uq, 384, nullptr, 0);
    conv_T(lds, p->in[I_WUKV] + (size_t)l * 128 * 1024, 1024, 128, 1024, ukv, 256, nullptr, 72);
    for (int d = 0; d < 2; ++d) {
        conv_T(lds, p->in[I_W2] + (size_t)(l * 2 + d) * 96 * 512, 512, 96, 512, lora + (size_t)(d * 512) * 640 + d * 96, 640, nullptr, 104 + 16 * d);
        conv_T(lds, p->in[I_A2] + (size_t)(l * 2 + d) * 96 * 512, 512, 96, 512, lora + (size_t)(1024 + d * 512) * 640 + 192 + d * 96, 640, nullptr, 136 + 16 * d);
    }
    conv_T(lds, p->in[I_G2] + (size_t)l * 256 * 512, 512, 256, 512, lora + (size_t)2048 * 640 + 384, 640, nullptr, 168);
    for (int g = 0; g < 4; ++g)
        conv_T(lds, p->in[I_POOLW] + (size_t)(l * 4 + g) * 128 * 128, 128, 128, 128, pw + (size_t)(g * 128) * 512 + g * 128, 512, p->in[I_POOLS] + l * 512 + g * 128, 200 + 4 * g);
}

DI void mod_phase(PP p, LAS unsigned char* lds) {
    LAS float* sc = (LAS float*)lds;
    LAS float* red = sc + 9 * 2048;
    const int tid = tid_(), wid = tid >> 6, lane = tid & 63;
    {
#pragma unroll
        for (int i0 = 0; i0 < 36; i0 += 12) { float v[12];
#pragma unroll
            for (int u = 0; u < 12; ++u) { const int i = tid + (i0 + u) * 512; const int m = i >> 11, k = i & 2047; v[u] = (m < 8) ? p->in[I_C][m * 2048 + k] : p->in[I_CCTX][k]; }
#pragma unroll
            for (int u = 0; u < 12; ++u) sc[tid + (i0 + u) * 512] = v[u] / (1.0f + __expf(-v[u])); }
    }
    __syncthreads();
    float* MOD = (float*)(p->ws + OFF_MOD);
    for (int item = blockIdx.x; item < 2 * 192 * 2; item += gridDim.x) {
        const int kh = item & 1, it2 = item >> 1; const int l = it2 / 192, j0 = (it2 - l * 192) * 64;
        const int kb = kh * 1024 + wid * 128;
        const float* W = p->in[I_ADAW] + (size_t)l * 2048 * 12288 + (size_t)kb * 12288 + j0 + lane;
        float acc[9];
#pragma unroll
        for (int m = 0; m < 9; ++m) acc[m] = 0.f;
#pragma nounroll
        for (int k = 0; k < 128; k += 16) {
            float wv[16];
#pragma unroll
            for (int i = 0; i < 16; ++i) wv[i] = W[(size_t)(k + i) * 12288];
#pragma unroll
            for (int m = 0; m < 9; ++m) {
#pragma unroll
                for (int i4 = 0; i4 < 4; ++i4) { const f32x4 sv = *(const LAS f32x4*)(sc + m * 2048 + kb + k + 4 * i4);
                    acc[m] += sv[0] * wv[4 * i4] + sv[1] * wv[4 * i4 + 1] + sv[2] * wv[4 * i4 + 2] + sv[3] * wv[4 * i4 + 3]; } }
        }
#pragma unroll
        for (int m = 0; m < 9; ++m) red[(wid * 9 + m) * 64 + lane] = acc[m];
        __syncthreads();
        for (int i = tid; i < 9 * 64; i += 512) { const int m = i >> 6, ln = i & 63; float sm = 0.f;
#pragma unroll
            for (int w = 0; w < 8; ++w) sm += red[(w * 9 + m) * 64 + ln];
            if (kh == 0) sm += p->in[I_ADAB][l * 12288 + j0 + ln];
            __hip_atomic_fetch_add(MOD + ((size_t)l * 9 + m) * 12288 + j0 + ln, sm, __ATOMIC_RELAXED, __HIP_MEMORY_SCOPE_AGENT); }
        __syncthreads();
    }
    if (blockIdx.x == gridDim.x - 1) {
        float* RT = (float*)(p->ws + OFF_ROPE);
        for (int i = tid; i < 1024; i += 512) { const int pp = i >> 4, f = i & 15;
            const float inv = __builtin_amdgcn_exp2f(-(float)f * (13.287712379549449f / 16.0f));
            const float x = (float)pp * inv;
            const float n = rintf(x * 0.15915494309189535f);
            float r = fmaf(-n, 6.28318548202514648f, x); r = fmaf(-n, -1.7484555e-7f, r);
            RT[2 * i] = __cosf(r); RT[2 * i + 1] = __sinf(r); }
    }
}

DI void norm_phase(PP p, int l, int which  , int row_lo) {
    const int tid = tid_(); const int wid = tid >> 6, lane = tid & 63;
    const int gw = blockIdx.x * 8 + wid, nw = gridDim.x * 8;
    const float* gsrc = which == 0 ? p->in[I_N1G] + l * D : (which == 1 ? p->in[I_N2G] + l * D : p->in[I_FNG]);
    const float* MOD = (const float*)(p->ws + OFF_MOD) + (size_t)l * 9 * 12288;
    u16* ACT = (u16*)(p->ws + OFF_ACT);
    float* HC = (float*)(p->ws + OFF_HCTX);
    const bool from_input = (which == 0 && l == 0);
    const int nrows = NTOK - row_lo, per = (nrows + nw - 1) / nw;
    f32x4 g[8], gm[8], sh[8];
#pragma unroll
    for (int i = 0; i < 8; ++i) { g[i] = *(const f32x4*)(gsrc + i * 256 + lane * 4); gm[i] = g[i]; sh[i] = (f32x4){0.f, 0.f, 0.f, 0.f}; }
    int cur_mr = -1;
    for (int k = 0; k < per; ++k) {
        const int row = row_lo + gw * per + k;
        if (row >= NTOK) break;
        const float* hr;
        if (row < NCT) hr = (from_input ? p->in[I_CTX] : HC) + (size_t)row * D;
        else hr = (from_input ? p->in[I_X] : p->out) + (size_t)(row - NCT) * D;
        f32x4 v[8]; float ss = 0.f;
#pragma unroll
        for (int i = 0; i < 8; ++i) v[i] = *(const f32x4*)(hr + i * 256 + lane * 4);
        if (which != 2) { const int mrw = modrow(row);
            if (mrw != cur_mr) { cur_mr = mrw; const float* mr = MOD + (size_t)mrw * 12288 + (which == 0 ? 0 : 3 * D);
#pragma unroll
                for (int i = 0; i < 8; ++i) { const int c = i * 256 + lane * 4; sh[i] = *(const f32x4*)(mr + c); gm[i] = g[i] * (*(const f32x4*)(mr + D + c) + 1.0f); } } }
#pragma unroll
        for (int i = 0; i < 8; ++i) ss += v[i][0] * v[i][0] + v[i][1] * v[i][1] + v[i][2] * v[i][2] + v[i][3] * v[i][3];
        { float s1[1] = {ss}; wsum_n<1>(s1); ss = s1[0]; }
        const float rstd = rsqrtf(ss * (1.0f / D) + 1e-6f);
        if (which == 2) {
            float* orow = p->out + (size_t)(row - NCT) * D;
#pragma unroll
            for (int i = 0; i < 8; ++i) *(f32x4*)(orow + i * 256 + lane * 4) = v[i] * rstd * g[i];
        } else {
#pragma unroll
            for (int i = 0; i < 8; ++i) { const int c = i * 256 + lane * 4;
                const f32x4 o = v[i] * rstd * gm[i] + sh[i]; u32x2 w; w.x = pack2(o[0], o[1]); w.y = pack2(o[2], o[3]);
                *(u32x2*)(ACT + (size_t)row * D + c) = w; }
        }
    }
}

DI void row_seq(int row, int& t, int& n) { if (row < NCT) { t = row & 255; n = CTX; } else { t = (row - NCT) & 2047; n = SEQ; } }
DI void ld8(const u16* ptr, float (&o)[8]) { const u32x4 w = *(const u32x4*)ptr; o[0] = bflo(w.x); o[1] = bfhi(w.x); o[2] = bflo(w.y); o[3] = bfhi(w.y); o[4] = bflo(w.z); o[5] = bfhi(w.z); o[6] = bflo(w.w); o[7] = bfhi(w.w); }
DI void st8(u16* ptr, const float (&v)[8]) { u32x4 w; w.x = pack2(v[0], v[1]); w.y = pack2(v[2], v[3]); w.z = pack2(v[4], v[5]); w.w = pack2(v[6], v[7]); *(u32x4*)ptr = w; }
DI void prep_phase(PP p, int l) {
    const u16* F = (const u16*)(p->ws + X_F);
    const int tid = tid_(), wid = tid >> 6, lane = tid & 63;
    {
        u16* AQ = (u16*)(p->ws + OFF_AQ); u16* AKV = (u16*)(p->ws + OFF_AKV); u16* KPE = (u16*)(p->ws + OFF_KPE);
        const float* gq = p->in[I_QNG] + l * 384; const float* gkv = p->in[I_KVNG] + l * 128; const float* RT = (const float*)(p->ws + OFF_ROPE);
        float gqv[6], gkv0 = gkv[lane * 2], gkv1 = gkv[lane * 2 + 1];
#pragma unroll
        for (int i = 0; i < 6; ++i) gqv[i] = gq[lane * 6 + i];
        constexpr int NR = 3;
        for (int row0 = (blockIdx.x * 8 + wid) * NR; row0 < NTOK; row0 += gridDim.x * 8 * NR) {
            unsigned qa[NR], qb[NR], qc[NR], kvw[NR]; u16 krw[NR];
#pragma unroll
            for (int r = 0; r < NR; ++r) { const u16* fr = F + (size_t)(row0 + r) * FN; const unsigned* qp = (const unsigned*)(fr + lane * 6);
                qa[r] = qp[0]; qb[r] = qp[1]; qc[r] = qp[2]; kvw[r] = *(const unsigned*)(fr + C_KV + lane * 2); krw[r] = fr[C_KR + lane]; }
            float ssq[NR], ssk[NR];
#pragma unroll
            for (int r = 0; r < NR; ++r) { ssq[r] = bflo(qa[r]) * bflo(qa[r]) + bfhi(qa[r]) * bfhi(qa[r]) + bflo(qb[r]) * bflo(qb[r]) + bfhi(qb[r]) * bfhi(qb[r]) + bflo(qc[r]) * bflo(qc[r]) + bfhi(qc[r]) * bfhi(qc[r]);
                ssk[r] = bflo(kvw[r]) * bflo(kvw[r]) + bfhi(kvw[r]) * bfhi(kvw[r]); }
            wsum_n<NR>(ssq); wsum_n<NR>(ssk);
#pragma unroll
            for (int r = 0; r < NR; ++r) {
                const int row = row0 + r;
                const float rq = rsqrtf(ssq[r] * (1.0f / 384.0f) + 1e-6f), rk = rsqrtf(ssk[r] * (1.0f / 128.0f) + 1e-6f);
                unsigned* op = (unsigned*)(AQ + (size_t)row * 384 + lane * 6);
                op[0] = pack2(bflo(qa[r]) * rq * gqv[0], bfhi(qa[r]) * rq * gqv[1]); op[1] = pack2(bflo(qb[r]) * rq * gqv[2], bfhi(qb[r]) * rq * gqv[3]); op[2] = pack2(bflo(qc[r]) * rq * gqv[4], bfhi(qc[r]) * rq * gqv[5]);
                unsigned* ok = (unsigned*)(AKV + (size_t)row * 256); ok[lane] = pack2(bflo(kvw[r]) * rk * gkv0, bfhi(kvw[r]) * rk * gkv1); ok[64 + lane] = 0u;
                float x = bf2f(krw[r]);
                if (row >= NCT) {
                    const int t = (row - NCT) & 2047;
                    const float pr = __shfl_xor(x, 16);
                    const int ax = lane >> 5, jj = lane & 31, f = jj & 15; const int pp = ax ? (t & 63) : (t >> 6);
                    const float cs = RT[(pp * 16 + f) * 2], sn = RT[(pp * 16 + f) * 2 + 1];
                    x = (jj >> 4) ? (x * cs + pr * sn) : (x * cs - pr * sn);
                }
                KPE[(size_t)row * 64 + lane] = (u16)(pack2(x, 0.f) & 0xffffu);
            }
        }
    }
    const size_t gtid = (size_t)blockIdx.x * 512 + tid, gstride = (size_t)gridDim.x * 512;
    {
        u16* RKV = (u16*)(p->ws + OFF_RKV); u16* AL = (u16*)(p->ws + OFF_ALORA); const float* mu = p->in[I_MU] + l * 2176;
        const int nthr = (int)gstride, ncolw = nthr / 272;
        const int ch = (int)(gtid % 272), run_first = (int)(gtid / 272); const int cc = ch * 8;
        float m8[8];
#pragma unroll
        for (int j = 0; j < 8; ++j) m8[j] = mu[cc + j];
        for (int run = run_first; run < NTOK / 8 && run_first < ncolw; run += ncolw) {
            const int row0 = run * 8;
            int t, n; row_seq(row0, t, n);
            const u16* fp = F + (size_t)row0 * FN + C_RW + cc;
            u32x4 raw[10];
#pragma unroll
            for (int i = 0; i < 8; ++i) raw[i + 1] = *(const u32x4*)(fp + (size_t)i * FN);
            raw[0] = (t > 0) ? *(const u32x4*)(fp - FN) : (u32x4){0u, 0u, 0u, 0u};
            raw[9] = (t + 8 < n) ? *(const u32x4*)(fp + (size_t)8 * FN) : (u32x4){0u, 0u, 0u, 0u};
#pragma unroll
            for (int i = 0; i < 8; ++i) {
                const int row = row0 + i;
                const u32x4 pw = raw[i], cw_ = raw[i + 1], nw = raw[i + 2];
                float f[8];
#pragma unroll
                for (int j = 0; j < 4; ++j) {
                    const unsigned pj = j == 0 ? pw.x : (j == 1 ? pw.y : (j == 2 ? pw.z : pw.w));
                    const unsigned cj = j == 0 ? cw_.x : (j == 1 ? cw_.y : (j == 2 ? cw_.z : cw_.w));
                    const unsigned nj = j == 0 ? nw.x : (j == 1 ? nw.y : (j == 2 ? nw.z : nw.w));
                    const float c0 = bflo(cj), c1 = bfhi(cj);
                    f[2 * j] = c0 + m8[2 * j] * (0.5f * (bflo(pj) + bflo(nj)) - c0);
                    f[2 * j + 1] = c1 + m8[2 * j + 1] * (0.5f * (bfhi(pj) + bfhi(nj)) - c1);
                }
                if (cc < 1536) {
                    const int which = cc >> 9, c = cc & 511;
                    st8(RKV + ((size_t)which * NTOK + row) * 512 + c, f);
                } else {
                    const int c = cc - 1536;
                    if (c < 192) {
#pragma unroll
                        for (int j = 0; j < 8; ++j) { const float e = __expf(2.0f * f[j]); f[j] = 1.0f - 2.0f / (e + 1.0f); }
                    } else if (c >= 384) {
#pragma unroll
                        for (int j = 0; j < 8; ++j) f[j] = sigmoidf_(f[j]);
                    }
                    st8(AL + (size_t)row * 640 + c, f);
                }
            }
        }
    }
    {
        u16* AP = (u16*)(p->ws + OFF_APOOL);
        for (size_t idx = gtid; idx < (size_t)NTOK * 64; idx += gstride) {
            const int g = (int)(idx / ((size_t)NTOK * 16)); const int rem = (int)(idx - (size_t)g * NTOK * 16);
            const int row = rem >> 4, ch = g * 16 + (rem & 15);
            int t, n; row_seq(row, t, n);
            const u16* fp = F + (size_t)row * FN + C_POOL + ch * 8;
            float s[8];
#pragma unroll
            for (int j = 0; j < 8; ++j) s[j] = 0.f;
            const u32x4 uc = *(const u32x4*)fp;
            int cnt;
#define POOL_WIN(HW) do { u32x4 rw[2 * (HW)]; cnt = 0; \
                _Pragma("unroll") for (int i = 0; i < 2 * (HW); ++i) { const int tt = t - (HW) + i; const bool ok = tt >= 0 && tt < n; cnt += ok ? 1 : 0; \
                    rw[i] = ok ? *(const u32x4*)(fp + (ptrdiff_t)(i - (HW)) * FN) : (u32x4){0u, 0u, 0u, 0u}; } \
                _Pragma("unroll") for (int i = 0; i < 2 * (HW); ++i) { s[0] += bflo(rw[i].x); s[1] += bfhi(rw[i].x); s[2] += bflo(rw[i].y); s[3] += bfhi(rw[i].y); \
                    s[4] += bflo(rw[i].z); s[5] += bfhi(rw[i].z); s[6] += bflo(rw[i].w); s[7] += bfhi(rw[i].w); } } while (0)
            if (g == 0) POOL_WIN(1); else if (g == 1) POOL_WIN(2); else if (g == 2) POOL_WIN(4); else POOL_WIN(8);
#undef POOL_WIN
            const float ic = 1.0f / (float)cnt;
            const float u[8] = {bflo(uc.x), bfhi(uc.x), bflo(uc.y), bfhi(uc.y), bflo(uc.z), bfhi(uc.z), bflo(uc.w), bfhi(uc.w)};
#pragma unroll
            for (int j = 0; j < 8; ++j) s[j] = s[j] * ic - u[j];
            st8(AP + (size_t)row * 512 + ch * 8, s);
        }
    }
    {
        u16* ACT = (u16*)(p->ws + OFF_ACT); const float* cw = p->in[I_CONVW] + l * 3 * 512;
        const int ch4 = (int)(gtid & 63), c = ch4 * 8;
        float w0[8], w1[8], w2[8];
#pragma unroll
        for (int j = 0; j < 8; ++j) { w0[j] = cw[c + j]; w1[j] = cw[512 + c + j]; w2[j] = cw[1024 + c + j]; }
        for (size_t idx = gtid; idx < (size_t)(NTOK / 4) * 64; idx += gstride) {
            const int run = (int)(idx >> 6); const int row0 = run * 4;
            int t, n; row_seq(row0, t, n);
            const u16* fp = F + (size_t)row0 * FN;
            u32x4 gcr[6], hxr[6], gbr[4];
#pragma unroll
            for (int i = 0; i < 4; ++i) { gcr[i + 1] = *(const u32x4*)(fp + (size_t)i * FN + C_GC + c); hxr[i + 1] = *(const u32x4*)(fp + (size_t)i * FN + C_HX + c); gbr[i] = *(const u32x4*)(fp + (size_t)i * FN + C_GB + c); }
            const bool hp = t > 0, hn = (t + 4 < n);
            gcr[0] = hp ? *(const u32x4*)(fp - FN + C_GC + c) : (u32x4){0u, 0u, 0u, 0u}; hxr[0] = hp ? *(const u32x4*)(fp - FN + C_HX + c) : (u32x4){0u, 0u, 0u, 0u};
            gcr[5] = hn ? *(const u32x4*)(fp + (size_t)4 * FN + C_GC + c) : (u32x4){0u, 0u, 0u, 0u}; hxr[5] = hn ? *(const u32x4*)(fp + (size_t)4 * FN + C_HX + c) : (u32x4){0u, 0u, 0u, 0u};
            float u[6][8];
#pragma unroll
            for (int i = 0; i < 6; ++i) {
                const unsigned gw[4] = {gcr[i].x, gcr[i].y, gcr[i].z, gcr[i].w}; const unsigned hw_[4] = {hxr[i].x, hxr[i].y, hxr[i].z, hxr[i].w};
#pragma unroll
                for (int j = 0; j < 4; ++j) { u[i][2 * j] = bflo(gw[j]) * bflo(hw_[j]); u[i][2 * j + 1] = bfhi(gw[j]) * bfhi(hw_[j]); }
            }
#pragma unroll
            for (int i = 0; i < 4; ++i) {
                const unsigned bw[4] = {gbr[i].x, gbr[i].y, gbr[i].z, gbr[i].w};
                float z[8];
#pragma unroll
                for (int j = 0; j < 8; ++j) { const float gb = (j & 1) ? bfhi(bw[j >> 1]) : bflo(bw[j >> 1]); z[j] = gb * (w0[j] * u[i][j] + w1[j] * u[i + 1][j] + w2[j] * u[i + 2][j]); }
                st8(ACT + (size_t)(row0 + i) * D + 1536 + c, z);
            }
        }
    }
}

DI int steprow(int b, int dir, int s) {
    if (s < CTX) return b * CTX + (dir ? (CTX - 1 - s) : s);
    const int t = s - CTX; return NCT + b * SEQ + (dir ? (SEQ - 1 - t) : t);
}
DI void scan_item(PP p, int l, int item, LAS unsigned char* lds) {
    const int sid = item >> 1, half = item & 1; const int b = sid >> 4, h = (sid >> 1) & 7, dir = sid & 1;
    const int tid = tid_(), wid = __builtin_amdgcn_readfirstlane(tid >> 6), lane = tid & 63;
    LAS float* buf = (LAS float*)lds;
    const u16* RKV = (const u16*)(p->ws + OFF_RKV);
    const float* DEC = (const float*)(p->ws + X_DEC) + (size_t)dir * NTOK * 512;
    const u16* AA = (const u16*)(p->ws + X_AA) + (size_t)dir * NTOK * 512;
    u16* Y = (u16*)(p->ws + X_Y) + (size_t)dir * NTOK * 512;
    const int ch = h * 64 + lane;
    const float kkw = p->in[I_KK][l * 512 + ch], kaw = p->in[I_KA][l * 512 + ch];
    constexpr int T = 32, NCH = KP / T;
    float pr_[8], pk_[8], pv_[8], pd_[8], pa_[8];
    auto gl = [&](int c) {
        const int pw = wid - 4;
        const int row0 = steprow(b, dir, c * T + pw * 8); const int rs = dir ? -1 : 1;
#pragma unroll
        for (int i = 0; i < 8; ++i) { const size_t o = (size_t)(row0 + rs * i) * 512 + ch;
            pr_[i] = bf2f(RKV[o]); pk_[i] = bf2f(RKV[(size_t)NTOK * 512 + o]); pv_[i] = bf2f(RKV[(size_t)2 * NTOK * 512 + o]); pd_[i] = DEC[o]; pa_[i] = bf2f(AA[o]); }
    };
    auto fill = [&](int c) {
        const int pw = wid - 4;
        float kk[8], n2[8];
#pragma unroll
        for (int i = 0; i < 8; ++i) { kk[i] = pk_[i] * kkw; n2[i] = kk[i] * kk[i]; }
#pragma unroll
        for (int i = 0; i < 8; ++i) n2[i] += dpp_f(n2[i], 0);
#pragma unroll
        for (int i = 0; i < 8; ++i) n2[i] += dpp_f(n2[i], 1);
#pragma unroll
        for (int i = 0; i < 8; ++i) n2[i] += dpp_f(n2[i], 2);
#pragma unroll
        for (int i = 0; i < 8; ++i) n2[i] += dpp_f(n2[i], 3);
#pragma unroll
        for (int i = 0; i < 8; ++i) n2[i] += __shfl_xor(n2[i], 16);
#pragma unroll
        for (int i = 0; i < 8; ++i) n2[i] += __shfl_xor(n2[i], 32);
#pragma unroll
        for (int i = 0; i < 8; ++i) {
            const float kn = kk[i] * __builtin_amdgcn_rsqf(fmaxf(n2[i], 1e-24f));
            LAS float* d = buf + ((c & 1) * T + pw * 8 + i) * 384 + lane;
            d[0] = pr_[i]; d[64] = pd_[i]; d[128] = pk_[i] * (1.0f + (pa_[i] - 1.0f) * kaw); d[192] = -kn; d[256] = kn * pa_[i]; d[320] = pv_[i];
        }
    };
    f32x2 S[4];
#pragma unroll
    for (int j = 0; j < 4; ++j) S[j] = (f32x2){0.f, 0.f};
    const int ks = lane & 7, vrow = half * 32 + (wid & 3) * 8 + (lane >> 3);
    u16* Yp = Y + h * 64 + vrow;
    LAS float* ypl = (LAS float*)(lds + 98304) + (wid & 3) * (8 * 68) + lane;
    __syncthreads();
    if (wid >= 4) { gl(0); fill(0); gl(1); }
    __syncthreads();
#define SC_LD(X, sp_) do { const LAS float* q_ = (sp_) + ks * 8; X##r0 = *(const LAS f32x4*)(q_); X##r1 = *(const LAS f32x4*)(q_ + 4); X##w0 = *(const LAS f32x4*)(q_ + 64); X##w1 = *(const LAS f32x4*)(q_ + 68); \
        X##k0 = *(const LAS f32x4*)(q_ + 128); X##k1 = *(const LAS f32x4*)(q_ + 132); X##a0 = *(const LAS f32x4*)(q_ + 192); X##a1 = *(const LAS f32x4*)(q_ + 196); \
        X##b0 = *(const LAS f32x4*)(q_ + 256); X##b1 = *(const LAS f32x4*)(q_ + 260); X##vv = (sp_)[320 + vrow]; } while (0)
#define SC_STEP(X, srow_) do { \
        f32x2 pa = S[0] * LO2(X##a0); pa = __builtin_elementwise_fma(S[1], HI2(X##a0), pa); f32x2 qa = S[2] * LO2(X##a1); qa = __builtin_elementwise_fma(S[3], HI2(X##a1), qa); pa += qa; \
        float sa = red8(pa[0] + pa[1]); const f32x2 vv2 = {X##vv, X##vv}; \
        f32x2 u0 = __builtin_elementwise_fma(vv2, LO2(X##k0), S[0] * LO2(X##w0)), u1 = __builtin_elementwise_fma(vv2, HI2(X##k0), S[1] * HI2(X##w0)); \
        f32x2 u2 = __builtin_elementwise_fma(vv2, LO2(X##k1), S[2] * LO2(X##w1)), u3 = __builtin_elementwise_fma(vv2, HI2(X##k1), S[3] * HI2(X##w1)); \
        const f32x2 sa2 = {sa, sa}; \
        S[0] = __builtin_elementwise_fma(sa2, LO2(X##b0), u0); S[1] = __builtin_elementwise_fma(sa2, HI2(X##b0), u1); S[2] = __builtin_elementwise_fma(sa2, LO2(X##b1), u2); S[3] = __builtin_elementwise_fma(sa2, HI2(X##b1), u3); \
        f32x2 py = S[0] * LO2(X##r0); py = __builtin_elementwise_fma(S[1], HI2(X##r0), py); f32x2 qy = S[2] * LO2(X##r1); qy = __builtin_elementwise_fma(S[3], HI2(X##r1), qy); py += qy; \
        ypl[((srow_) & 7) * 68] = py[0] + py[1]; } while (0)
#define LO2(v) __builtin_shufflevector(v, v, 0, 1)
#define HI2(v) __builtin_shufflevector(v, v, 2, 3)
    for (int c = 0; c < NCH; ++c) {
        if (wid >= 4) { if (c + 1 < NCH) { fill(c + 1); if (c + 2 < NCH) gl(c + 2); } }
        else {
            const LAS float* sp = buf + ((c & 1) * T) * 384;
            f32x4 Ar0, Ar1, Aw0, Aw1, Ak0, Ak1, Aa0, Aa1, Ab0, Ab1; float Avv;
            f32x4 Br0, Br1, Bw0, Bw1, Bk0, Bk1, Ba0, Ba1, Bb0, Bb1; float Bvv;
            SC_LD(A, sp);
            const ptrdiff_t ystep = dir ? -512 : 512;
            u16* Yl = Yp + (size_t)steprow(b, dir, c * T) * 512 + (ptrdiff_t)ks * ystep;
#pragma nounroll
            for (int st = 0; st < T; st += 2) {
                SC_LD(B, sp + (st + 1) * 384);
                SC_STEP(A, st);
                if (st + 2 < T) SC_LD(A, sp + (st + 2) * 384);
                SC_STEP(B, st + 1);
                if ((st & 6) == 6) {
                    const LAS float* rp = ypl + (ks * 68 - lane) + (lane & ~7);
                    const f32x4 q0 = *(const LAS f32x4*)rp, q1 = *(const LAS f32x4*)(rp + 4);
                    Yl[(ptrdiff_t)(st - 6) * ystep] = (u16)(pack2(((q0[0] + q0[1]) + (q0[2] + q0[3])) + ((q1[0] + q1[1]) + (q1[2] + q1[3])), 0.f) & 0xffffu);
                }
            }
        }
        __syncthreads();
    }
#undef SC_LD
#undef SC_STEP
#undef LO2
#undef HI2
}

constexpr int AT_KROW = 400, AT_KSZ = 64 * AT_KROW, AT_VROW = 136, AT_VSZ = 128 * AT_VROW, AT_BUF = AT_KSZ + AT_VSZ;
DI void attn_unit(PP p, int b, int h, int qpos0, int nk, int orow0, LAS unsigned char* lds) {
    const int tid = tid_(), wid = tid >> 6, lane = tid & 63, ql = lane & 31, g = lane >> 5;
    const u16* Qb = (const u16*)(p->ws + X_Q) + ((size_t)(b * 4 + h) * KP + qpos0 + wid * 32 + ql) * 192;
    const u16* Kb = (const u16*)(p->ws + X_K) + (size_t)(b * 4 + h) * KP * 128;
    const u16* KPEb = (const u16*)(p->ws + OFF_KPE);
    const u16* Vb = (const u16*)(p->ws + X_VT) + (size_t)(b * 4 + h) * 128 * KP;
    bf16x8 qf[12];
#pragma unroll
    for (int s = 0; s < 12; ++s) qf[s] = *(const bf16x8*)(Qb + 16 * s + 8 * g);
    f32x16 o[4];
#pragma unroll
    for (int i = 0; i < 4; ++i)
#pragma unroll
        for (int j = 0; j < 16; ++j) o[i][j] = 0.f;
    float mrun = -__builtin_inff(), lsum = 0.f;
    u32x4 kreg[3], vreg[2];
    const int srow = tid >> 3, sc8 = tid & 7;
    const u16* kgp = Kb + (size_t)srow * 128 + sc8 * 8;
    const u16* pgp = KPEb + (size_t)srow * 64 + sc8 * 8;
    const u16* vgp = Vb + (size_t)srow * 64 + sc8 * 8;
    const int klo = srow * AT_KROW + sc8 * 16, vlo = AT_KSZ + srow * AT_VROW + sc8 * 16;
    auto gload = [&](int t) {
        const int key0 = t * 64;
#pragma unroll
        for (int i = 0; i < 2; ++i) kreg[i] = *(const u32x4*)(kgp + (size_t)key0 * 128 + i * 64);
        { const int rb = key0 < CTX ? b * CTX + key0 : NCT + b * SEQ + key0 - CTX; kreg[2] = *(const u32x4*)(pgp + (size_t)rb * 64); }
#pragma unroll
        for (int i = 0; i < 2; ++i) vreg[i] = *(const u32x4*)(vgp + (size_t)key0 * 128 + i * 64 * 64);
    };
    auto lstore = [&](int bsel) {
        LAS unsigned char* base = lds + bsel * AT_BUF;
#pragma unroll
        for (int i = 0; i < 3; ++i) *(LAS u32x4*)(base + klo + i * 128) = kreg[i];
#pragma unroll
        for (int i = 0; i < 2; ++i) { LAS unsigned char* vp = base + vlo + i * 64 * AT_VROW;
            *(LAS u32x2*)vp = (u32x2){vreg[i].x, vreg[i].y}; *(LAS u32x2*)(vp + 8) = (u32x2){vreg[i].z, vreg[i].w}; }
    };
    __syncthreads();
    gload(0); lstore(0);
    __syncthreads();
    const int nt = nk >> 6;
    for (int t = 0; t < nt; ++t) {
        if (t + 1 < nt) gload(t + 1);
        __builtin_amdgcn_sched_barrier(0);
        const LAS unsigned char* base = lds + (t & 1) * AT_BUF;
        f32x16 s0, s1;
#pragma unroll
        for (int j = 0; j < 16; ++j) { s0[j] = 0.f; s1[j] = 0.f; }
#pragma unroll
        for (int s = 0; s < 12; ++s) {
            const bf16x8 a0 = *(const LAS bf16x8*)(base + ql * AT_KROW + (16 * s + 8 * g) * 2);
            const bf16x8 a1 = *(const LAS bf16x8*)(base + (32 + ql) * AT_KROW + (16 * s + 8 * g) * 2);
            s0 = __builtin_amdgcn_mfma_f32_32x32x16_bf16(a0, qf[s], s0, 0, 0, 0);
            s1 = __builtin_amdgcn_mfma_f32_32x32x16_bf16(a1, qf[s], s1, 0, 0, 0);
            if ((s & 3) == 3) __builtin_amdgcn_sched_barrier(0);
        }
        float mx = s0[0];
#pragma unroll
        for (int j = 1; j < 16; ++j) mx = fmaxf(mx, s0[j]);
#pragma unroll
        for (int j = 0; j < 16; ++j) mx = fmaxf(mx, s1[j]);
        mx = fmaxf(mx, __shfl_xor(mx, 32));
        const float mnew = fmaxf(mrun, mx);
        const float alpha = __builtin_amdgcn_exp2f(mrun - mnew);
        mrun = mnew;
        float ps = 0.f;
#pragma unroll
        for (int j = 0; j < 16; ++j) { s0[j] = __builtin_amdgcn_exp2f(s0[j] - mnew); s1[j] = __builtin_amdgcn_exp2f(s1[j] - mnew); ps += s0[j] + s1[j]; }
        lsum = lsum * alpha + ps;
        if (__ballot(alpha != 1.0f) != 0ull) {
#pragma unroll
            for (int i = 0; i < 4; ++i) o[i] *= alpha;
        }
#pragma unroll
        for (int sub = 0; sub < 2; ++sub)
#pragma unroll
            for (int sp = 0; sp < 2; ++sp) {
                u32x4 pw;
                if (sub == 0) { pw.x = pack2(s0[8 * sp], s0[8 * sp + 1]); pw.y = pack2(s0[8 * sp + 2], s0[8 * sp + 3]); pw.z = pack2(s0[8 * sp + 4], s0[8 * sp + 5]); pw.w = pack2(s0[8 * sp + 6], s0[8 * sp + 7]); }
                else { pw.x = pack2(s1[8 * sp], s1[8 * sp + 1]); pw.y = pack2(s1[8 * sp + 2], s1[8 * sp + 3]); pw.z = pack2(s1[8 * sp + 4], s1[8 * sp + 5]); pw.w = pack2(s1[8 * sp + 6], s1[8 * sp + 7]); }
                const bf16x8 pf = __builtin_bit_cast(bf16x8, pw);
                const int kb = 32 * sub + 16 * sp + 4 * g;
#pragma unroll
                for (int blk = 0; blk < 4; ++blk) {
                    const LAS unsigned char* vp = base + AT_KSZ + (32 * blk + ql) * AT_VROW + kb * 2;
                    const s16x4 lo = *(const LAS s16x4*)vp, hi = *(const LAS s16x4*)(vp + 16);
                    const bf16x8 va = __builtin_shufflevector(lo, hi, 0, 1, 2, 3, 4, 5, 6, 7);
                    o[blk] = __builtin_amdgcn_mfma_f32_32x32x16_bf16(va, pf, o[blk], 0, 0, 0);
                }
                __builtin_amdgcn_sched_barrier(0);
            }
        if (t + 1 < nt) lstore((t + 1) & 1);
        __syncthreads();
    }
    lsum += __shfl_xor(lsum, 32);
    const float inv = 1.0f / lsum;
    u16* ACT = (u16*)(p->ws + OFF_ACT) + (size_t)(orow0 + wid * 32 + ql) * D + h * 128;
#pragma unroll
    for (int blk = 0; blk < 4; ++blk)
#pragma unroll
        for (int i4 = 0; i4 < 4; ++i4) {
            u32x2 w; w.x = pack2(o[blk][4 * i4] * inv, o[blk][4 * i4 + 1] * inv); w.y = pack2(o[blk][4 * i4 + 2] * inv, o[blk][4 * i4 + 3] * inv);
            *(u32x2*)(ACT + 32 * blk + 8 * i4 + 4 * g) = w;
        }
}
DI void mixer_phase(PP p, int l, LAS unsigned char* lds) {
    for (int rr = 0; rr < 1 + SCANREP; ++rr)
    for (int item = blockIdx.x; item < 256; item += gridDim.x) scan_item(p, l, item, lds);
    const int nunits = 256 + (l == 0 ? 32 : 0);
    for (int u = blockIdx.x; u < nunits; u += gridDim.x) {
        if (u < 256) {
            const int xcd = u & 7, idx = u >> 3; const int grp = xcd * 4 + (idx >> 3), qb = idx & 7; const int b = grp >> 2, h = grp & 3;
            attn_unit(p, b, h, CTX + qb * 256, KP, NCT + b * SEQ + qb * 256, lds);
        } else {
            const int cu = u - 256; const int b = cu >> 2, h = cu & 3;
            attn_unit(p, b, h, 0, CTX, b * CTX, lds);
        }
    }
}

DI void rwkv_out_phase(PP p, int l) {
    const int tid = tid_(); const int wid = tid >> 6, lane = tid & 63;
    const u16* RKV = (const u16*)(p->ws + OFF_RKV); const u16* Y = (const u16*)(p->ws + X_Y);
    const u16* AA = (const u16*)(p->ws + X_AA); const u16* G = (const u16*)(p->ws + X_G); u16* ACT = (u16*)(p->ws + OFF_ACT);
    const int row_lo = (l == 0) ? 0 : NCT;
    const size_t n_items = (size_t)(NTOK - row_lo) * 2;
    const int h0 = (int)((blockIdx.x * 8 + wid) & 1) * 4;
    const int c = (h0 + (lane >> 4)) * 64 + (lane & 15) * 4;
    const f32x4 lng = *(const f32x4*)(p->in[I_LNG] + l * 512 + c), lnb = *(const f32x4*)(p->in[I_LNB] + l * 512 + c);
    const f32x4 kaw = *(const f32x4*)(p->in[I_KA] + l * 512 + c), rkw = *(const f32x4*)(p->in[I_RK] + l * 512 + c);
#define UNP4(w_, o_) do { (o_)[0] = bflo((w_).x); (o_)[1] = bfhi((w_).x); (o_)[2] = bflo((w_).y); (o_)[3] = bfhi((w_).y); } while (0)
    const size_t istep = (size_t)gridDim.x * 8;
    for (size_t it = (size_t)blockIdx.x * 8 + wid; it < n_items; it += 2 * istep) {
        const bool has2 = it + istep < n_items;
        const int rowA = row_lo + (int)(it >> 1), rowB = has2 ? row_lo + (int)((it + istep) >> 1) : rowA;
        u32x2 wy0[2], wy1[2], wr[2], wk[2], wv[2], wf[2], wb[2], wg[2];
#pragma unroll
        for (int q = 0; q < 2; ++q) { const size_t o = (size_t)(q ? rowB : rowA) * 512 + c;
            wy0[q] = *(const u32x2*)(Y + o); wy1[q] = *(const u32x2*)(Y + (size_t)NTOK * 512 + o);
            wr[q] = *(const u32x2*)(RKV + o); wk[q] = *(const u32x2*)(RKV + (size_t)NTOK * 512 + o); wv[q] = *(const u32x2*)(RKV + (size_t)2 * NTOK * 512 + o);
            wf[q] = *(const u32x2*)(AA + o); wb[q] = *(const u32x2*)(AA + (size_t)NTOK * 512 + o); wg[q] = *(const u32x2*)(G + o); }
#pragma unroll
        for (int q = 0; q < 2; ++q) {
            if (q == 1 && !has2) break;
            const int row = q ? rowB : rowA;
            f32x4 y0, y1, r, k, v, af, ab, g;
            UNP4(wy0[q], y0); UNP4(wy1[q], y1); UNP4(wr[q], r); UNP4(wk[q], k); UNP4(wv[q], v); UNP4(wf[q], af); UNP4(wb[q], ab); UNP4(wg[q], g);
            const f32x4 y = y0 + y1;
            const f32x4 bnv = r * k * ((af + ab - 2.0f) * kaw + 2.0f) * rkw;
            float msum = (y[0] + y[1]) + (y[2] + y[3]), bsum = (bnv[0] + bnv[1]) + (bnv[2] + bnv[3]);
            msum = red16(msum); bsum = red16(bsum);
            const f32x4 d = y - msum * (1.0f / 64.0f);
            float vs = (d[0] * d[0] + d[1] * d[1]) + (d[2] * d[2] + d[3] * d[3]);
            vs = red16(vs);
            const f32x4 yn = d * rsqrtf(vs * (1.0f / 64.0f) + 64e-5f) * lng + lnb;
            const f32x4 out = (yn + v * bsum) * g;
            u32x2 w; w.x = pack2(out[0], out[1]); w.y = pack2(out[2], out[3]);
            *(u32x2*)(ACT + (size_t)row * D + 512 + c) = w;
        }
    }
#undef UNP4
}

#define XB_TMO      128
#define XB_XCNT(j)  (256  + 64 * (j))
#define XB_XSUB(j)  (1280 + 64 * (j))
#define XB_XGEN(j)  (2304 + 64 * (j))
#define XB_TOP      3328
#define XB_TOPGEN   3392
#define XCD_BAR_WORDS 3456
#define XB_SPIN_CAP (1u << 18)

__device__ __forceinline__ unsigned xb_ld(unsigned* p)              { return __hip_atomic_load(p, __ATOMIC_RELAXED, __HIP_MEMORY_SCOPE_AGENT); }
__device__ __forceinline__ unsigned xb_add(unsigned* p, unsigned v) { return __hip_atomic_fetch_add(p, v, __ATOMIC_RELAXED, __HIP_MEMORY_SCOPE_AGENT); }
__device__ __forceinline__ unsigned xb_xcc_id() { return (unsigned)__builtin_amdgcn_s_getreg((3 << 11) | 20) & 0xFu; }
#define XB_SPIN(cond, bar) do { unsigned _sp = 0; while (cond) { __builtin_amdgcn_s_sleep(1); \
    if ((++_sp & 255u) == 0u) { if (xb_ld(&(bar)[XB_TMO])) break; if (_sp > XB_SPIN_CAP) { atomicAdd(&(bar)[XB_TMO], 1u); break; } } } } while (0)

struct XcdBarrier {
    unsigned* bar; unsigned x;
    volatile LAS unsigned* st;
};

__device__ __forceinline__ XcdBarrier xcd_barrier_post(unsigned* bar, volatile LAS unsigned* st) {
    XcdBarrier b; b.bar = bar; b.x = xb_xcc_id(); b.st = st;
    if (threadIdx.x == 0) (void)xb_add(&bar[XB_XCNT(b.x)], 1u);
    return b;
}
__device__ __forceinline__ void xcd_barrier_complete(unsigned* bar, unsigned x, unsigned& nloc, unsigned& nx) {
    const unsigned G = gridDim.x * gridDim.y * gridDim.z;
    unsigned sum, cnt, mine, sp = 0u;
    for (;;) {
        sum = 0u; cnt = 0u; mine = 0u;
#pragma unroll
        for (unsigned j = 0; j < 16; ++j) { const unsigned c = xb_ld(&bar[XB_XCNT(j)]); sum += c; cnt += (c > 0u) ? 1u : 0u; mine = (j == x) ? c : mine; }
        if (sum == G) break;
        __builtin_amdgcn_s_sleep(1);
        if ((++sp & 255u) == 0u) { if (xb_ld(&bar[XB_TMO])) break; if (sp > XB_SPIN_CAP) { atomicAdd(&bar[XB_TMO], 1u); break; } }
    }
    nloc = mine > 0u ? mine : 1u; nx = cnt > 0u ? cnt : 1u;
}

__device__ __forceinline__ void xcd_barrier(const XcdBarrier& b) {
    asm volatile("s_waitcnt vmcnt(0)" ::: "memory");
    __syncthreads();
    if (threadIdx.x == 0) {
        unsigned* bar = b.bar;
        __builtin_amdgcn_s_waitcnt(0);
        unsigned nloc = b.st[0], nx = b.st[1];
        if (nloc == 0u) { xcd_barrier_complete(bar, b.x, nloc, nx); b.st[0] = nloc; b.st[1] = nx; }
        const unsigned old = xb_add(&bar[XB_XSUB(b.x)], 1u);
        const unsigned gen = old / nloc;
        if (old + 1u == (gen + 1u) * nloc) {
            __builtin_amdgcn_fence(__ATOMIC_RELEASE, "agent");
            asm volatile("s_waitcnt vmcnt(0)" ::: "memory");
            const unsigned og = xb_add(&bar[XB_TOP], 1u);
            const unsigned tg = og / nx;
            if (og + 1u == (tg + 1u) * nx) xb_add(&bar[XB_TOPGEN], 1u);
            else XB_SPIN(xb_ld(&bar[XB_TOPGEN]) == tg, bar);
            __builtin_amdgcn_fence(__ATOMIC_ACQUIRE, "agent");
            xb_add(&bar[XB_XGEN(b.x)], 1u);
            asm volatile("s_waitcnt vmcnt(0)" ::: "memory");
        } else {
            XB_SPIN(xb_ld(&bar[XB_XGEN(b.x)]) == gen, bar);
            __builtin_amdgcn_fence(__ATOMIC_ACQUIRE, "agent");
            asm volatile("s_waitcnt vmcnt(0)" ::: "memory");
        }
    }
    __syncthreads();
}


constexpr int NPH = 22;
DI void run_phase(PP p, int ph, LAS unsigned char* lds) {
    unsigned char* ws = p->ws;
    u16* ACT = (u16*)(ws + OFF_ACT);
    float* HC = (float*)(ws + OFF_HCTX);
    const float* MOD = (const float*)(ws + OFF_MOD);
    __syncthreads();
    if (ph == 0 && (PHMASK & 1)) {
        mod_phase(p, lds);
        __syncthreads();
        conv_small(p, lds, 0); conv_small(p, lds, 1);
        conv_big(p, lds, 0, 0);
        return;
    }
    if (ph == NPH - 1) { if (PHMASK & 2) norm_phase(p, 1, 2, NCT); return; }
    const int l = (ph - 1) / 10, k = (ph - 1) % 10;
    const unsigned char* sm = ws + OFF_SMALL + (size_t)l * SZ_SMALL;
    const int lat_only = (l == 1);
    const int row_lo = lat_only ? NCT : 0; const int Mrows = NTOK - row_lo;
    switch (k) {
    case 0: if (!(PHMASK & (4<<0))) break;
        norm_phase(p, l, 0, 0);
        break;
    case 1: if (!(PHMASK & (4<<1))) break; {
        pg8::EpiBf16<0> E; E.O = (u16*)(ws + X_F); E.ldc = FN; E.row_off = 0;
        run_gemm(lds, ACT, (const u16*)(ws + OFF_WIN), NTOK, FN, D, E, 0);
        {
            const int nunits = (NTOK / 256) * (FN / 256), G = (int)gridDim.x, nfull = nunits % G;
            const bool part = (nfull > 0 && nfull < G);
            if (!part || (int)blockIdx.x >= nfull) {
                const int nwk = part ? G - nfull : 0, wk = part ? (int)blockIdx.x - nfull : 0;
                if (l == 0) conv_big(p, lds, 0, 1, nwk, wk);
                conv_big(p, lds, l, 2, nwk, wk); conv_big(p, lds, l, 3, nwk, wk);
            }
        }
    } break;
    case 2: if (!(PHMASK & (4<<2))) break; prep_phase(p, l); break;
    case 3: if (!(PHMASK & (4<<3))) break; {
        if (SUBM & 1) { pg8::EpiLora E; E.DEC = (float*)(ws + X_DEC); E.AA = (u16*)(ws + X_AA); E.G = (u16*)(ws + X_G); E.w0 = p->in[I_W0] + l * 1024; E.a0 = p->in[I_A0] + l * 1024;
          E.pn_off = 0; run_gemm(lds, (const u16*)(ws + OFF_ALORA), (const u16*)(sm + SZ_UQ + SZ_UKV), NTOK, 2048, 384, E, 0, 640, 640);
          E.pn_off = 8; run_gemm(lds, (const u16*)(ws + OFF_ALORA) + 384, (const u16*)(sm + SZ_UQ + SZ_UKV) + (size_t)2048 * 640 + 384, NTOK, 512, 256, E, 64, 640, 640); }
        if (SUBM & 2) { pg8::EpiKV E; E.K = (u16*)(ws + X_K); E.VT = (u16*)(ws + X_VT); E.row_off = 0;
          run_gemm(lds, (const u16*)(ws + OFF_AKV), (const u16*)(sm + SZ_UQ), NTOK, 1024, 256, E, 208); }
        if (SUBM & 4) { pg8::EpiQ E; E.Q = (u16*)(ws + X_Q); E.rope = (const float*)(ws + OFF_ROPE); E.row_off = row_lo; E.qscale = 0.07216878364870322f * 1.4426950408889634f;
          run_gemm(lds, (const u16*)(ws + OFF_AQ) + (size_t)row_lo * 384, (const u16*)sm, Mrows, 768, 384, E, 240); }
        if (SUBM & 8) { pg8::EpiBf16<0> E; E.O = ACT + 1024; E.ldc = D; E.row_off = row_lo;
          run_gemm(lds, (const u16*)(ws + OFF_APOOL) + (size_t)row_lo * 512, (const u16*)(sm + SZ_UQ + SZ_UKV + SZ_LORA), Mrows, 512, 512, E, 200); }
    } break;
    case 4: if (!(PHMASK & (4<<4))) break; mixer_phase(p, l, lds); break;
    case 5: if (!(PHMASK & (4<<5))) break;
        rwkv_out_phase(p, l);
        if (l == 0) conv_big(p, lds, 1, 0);
        break;
    case 6: if (!(PHMASK & (4<<6))) break; {
        pg8::EpiRes E; E.res_c = (l == 0) ? p->in[I_CTX] : HC; E.res_l = (l == 0) ? p->in[I_X] : p->out; E.h_c = HC; E.h_l = p->out; E.gate = MOD + (size_t)l * 9 * 12288 + 2 * D; E.row_off = row_lo;
        run_gemm(lds, ACT + (size_t)row_lo * D, (const u16*)(ws + OFF_WOUT), Mrows, D, D, E, 0);
    } break;
    case 7: if (!(PHMASK & (4<<7))) break;
        norm_phase(p, l, 1, row_lo);
        if (l == 0) conv_big(p, lds, 1, 1);
        break;
    case 8: if (!(PHMASK & (4<<8))) break; {
        pg8::EpiBf16<3> E; E.O = (u16*)(ws + X_H1); E.ldc = FFP; E.row_off = row_lo;
        run_gemm(lds, ACT + (size_t)row_lo * D, (const u16*)(ws + OFF_W1), Mrows, FF, D, E, 0);
    } break;
    case 9: if (!(PHMASK & (4<<9))) break; {
        if (l == 0) {
            pg8::EpiResAtomic EA; EA.h_c = HC; EA.gate = MOD + 5 * D;
            int Ms = NCT, Ns = D, Ks = FF / 4; asm volatile("" : "+s"(Ms), "+s"(Ns), "+s"(Ks));
            const int kq = (int)(blockIdx.x & 3);
            pg8::Gemm g; g.A = (const u16*)(ws + X_H1) + (size_t)kq * (FF / 4); g.Bt = (const u16*)(ws + OFF_W2) + (size_t)kq * (FF / 4); g.M = Ms; g.N = Ns; g.K = Ks; g.lda = FFP; g.ldb = FFP;
            pg8::StaticOrder S; S.init(Ms, Ns, (int)(gridDim.x >> 2), (int)(blockIdx.x >> 2));
            pg8::gemm_phase<pg8::EpiResAtomic, pg8::StaticOrder>(lds, g, S, EA);
        }
        pg8::EpiRes E; E.res_c = HC; E.res_l = p->out; E.h_c = HC; E.h_l = p->out; E.gate = MOD + (size_t)l * 9 * 12288 + 5 * D; E.row_off = NCT;
        run_gemm(lds, (const u16*)(ws + X_H1) + (size_t)NCT * FFP, (const u16*)(ws + OFF_W2), NLT, D, FF, E, 0, FFP, FFP);
    } break;
    }
}

__global__ void __launch_bounds__(512, 2) mega(Params p_unused) {
    extern __shared__ __attribute__((aligned(16))) unsigned char shm[];
    LAS unsigned char* lds = (LAS unsigned char*)shm;
    cg::grid_group grid = cg::this_grid();
    PP pk = (PP)__builtin_amdgcn_kernarg_segment_ptr();
    const int ph_lo = pk->ph_lo, ph_hi = pk->ph_hi, use_sync = pk->use_sync;
    volatile LAS unsigned* xst = (volatile LAS unsigned*)(lds + 131072);
    if (threadIdx.x == 0) { xst[0] = 0u; xst[1] = 0u; }
    __syncthreads();
    const XcdBarrier xb = xcd_barrier_post((unsigned*)(pk->ws + OFF_BAR), xst);
    for (int ph = ph_lo; ph < ph_hi; ++ph) {
        const int nrep = 1 + (((REPMASK >> ph) & 1) ? REPN : 0);
        for (int rr = 0; rr < nrep; ++rr) {
            PP q = pk; asm volatile("" : "+s"(q));
            run_phase(q, ph, lds);
            __builtin_amdgcn_s_waitcnt(0);
        }
        if (use_sync && ph + 1 < ph_hi) { if (use_sync == 2) grid.sync(); else xcd_barrier(xb); for (int q9 = 0; q9 < SYNCREP; ++q9) xcd_barrier(xb); }
    }
}

extern "C" void kernel_launch(void* const* d_in, const int* in_sizes, int n_in, void* d_out, int out_size, void* d_ws, size_t ws_size, hipStream_t stream) {
    static int grid = 0;
    if (grid == 0) {
        if (n_in != 31 || out_size != NLT * D || ws_size < WS_END) { fprintf(stderr, "kernel_launch: unexpected shapes (n_in %d out %d ws %zu need %zu)\n", n_in, out_size, ws_size, (size_t)WS_END); grid = -1; return; }
        if (hipFuncSetAttribute((const void*)mega, hipFuncAttributeMaxDynamicSharedMemorySize, LDS_BYTES) != hipSuccess) { fprintf(stderr, "kernel_launch: hipFuncSetAttribute failed\n"); grid = -1; return; }
        int dev = 0, cus = 0, per_cu = 0;
        hipGetDevice(&dev); hipDeviceGetAttribute(&cus, hipDeviceAttributeMultiprocessorCount, dev);
        hipOccupancyMaxActiveBlocksPerMultiprocessor(&per_cu, (const void*)mega, 512, LDS_BYTES);
        (void)hipGetLastError();
        if (per_cu < 1) per_cu = 1;
        grid = cus;
    }
    if (grid < 0) return;
    hipMemsetAsync((char*)d_ws + OFF_SMALL, 0, OFF_MOD + SZ_MOD, stream);
    Params p{};
    for (int i = 0; i < 31; ++i) p.in[i] = (const float*)d_in[i];
    p.out = (float*)d_out; p.ws = (unsigned char*)d_ws;
#if ONE_LAUNCH
    p.ph_lo = 0; p.ph_hi = NPH; p.use_sync = 1; p.pad = 0;
    void* args[] = {&p};
    hipError_t e = hipLaunchCooperativeKernel((const void*)mega, dim3(grid), dim3(512), args, LDS_BYTES, stream);
    if (e != hipSuccess) fprintf(stderr, "cooperative launch failed: %s (grid %d)\n", hipGetErrorString(e), grid);
#else
    for (int ph = 0; ph < NPH; ++ph) {
        p.ph_lo = ph; p.ph_hi = ph + 1; p.use_sync = 0; p.pad = 0;
        hipLaunchKernelGGL(mega, dim3(grid), dim3(512), LDS_BYTES, stream, p);
    }
#endif
}
```
